# Optimizing an MI355X kernel written in HIP

```python
import math
import jax
import jax.numpy as jnp
from jax import lax
import numpy as np

D_MODEL = 2048
BATCH = 4
SEQ = 4096
DEPTH = 4

CTX_LEN = 256
GRID_W = 64
EPS = 1e-6
N_MOD = 6
D_MIX = D_MODEL
HY_W = D_MIX // 2
HY_GROUPS = 8
HY_ORDER = 2
HY_PROJ = (HY_ORDER + 1) * HY_W
HY_CONV = 3
HY_POS_EMB = 33
HY_FILT_H = 64
HY_TARGET = 1e-2
HY_FAST = 0.3
HY_SLOW = 1.5
SSD_W = D_MIX - HY_W
SSD_HEADDIM = 64
SSD_HEADS = SSD_W // SSD_HEADDIM
SSD_GROUPS = 2
SSD_HPG = SSD_HEADS // SSD_GROUPS
SSD_STATE = 128
SSD_CONV = 3
SSD_CHUNK = 128
SSD_XBC = SSD_W + 2 * SSD_GROUPS * SSD_STATE
SSD_DT = 2 * SSD_HEADS
PROJ_W = HY_PROJ + SSD_XBC + SSD_DT + SSD_W
D_FF = 4 * D_MODEL

kernel_name = 'hyena_ssd_parallel_prefix_dit'


def rmsnorm(x, w):
    xf = x.astype(jnp.float32)
    y = xf * lax.rsqrt(jnp.mean(xf * xf, axis=-1, keepdims=True) + EPS)
    return (y * w).astype(x.dtype)


def centred_dwconv(u, w, bias, grid):
    b, L, C = u.shape
    if grid is not None:
        u = u.reshape(b, grid[0], grid[1], C)
    K = w.shape[0]
    pad = K // 2
    T = u.shape[-2]
    up = jnp.pad(u, [(0, 0)] * (u.ndim - 2) + [(pad, pad), (0, 0)])
    y = bias + w[0] * up[..., 0:T, :]
    for k in range(1, K):
        y = y + w[k] * up[..., k:k + T, :]
    return y.reshape(b, L, C)


def hyena_kernel_fft(L, fw1, fb1, freq, fw2, fb2, fw3):
    f32 = jnp.float32
    t = jnp.linspace(0.0, 1.0, L, dtype=f32)[:, None]
    bands = (HY_POS_EMB - 1) // 2
    w = 2.0 * math.pi * jnp.arange(L, dtype=f32)[:, None] / L
    f = jnp.linspace(1e-4, bands - 1, bands, dtype=f32)[None, :]
    feats = jnp.concatenate([t, jnp.cos(f * w), -jnp.sin(f * w)], axis=-1)
    hdn = jnp.sin(freq * (feats @ fw1 + fb1))
    hdn = jnp.sin(freq * (hdn @ fw2 + fb2))
    h = (hdn @ fw3).astype(f32).reshape(L, HY_ORDER, 2, HY_W)
    deltas = jnp.linspace(math.log(HY_TARGET) / HY_SLOW, math.log(HY_TARGET) / HY_FAST, HY_W, dtype=f32)
    h = h * jnp.exp(-t[:, :, None, None] * jnp.abs(deltas))
    k = jnp.concatenate([h[:, :, 0], jnp.zeros((1, HY_ORDER, HY_W), f32), h[:0:-1, :, 1]], axis=0)
    k = k / (jnp.sum(jnp.abs(k), axis=0, keepdims=True) + EPS)
    return jnp.fft.rfft(k, axis=0)


def fft_conv(z, kf):
    L = z.shape[1]
    zf = jnp.fft.rfft(z, n=2 * L, axis=1)
    return jnp.fft.irfft(zf * kf[None], n=2 * L, axis=1)[:, :L]


def segsum(a):
    T = a.shape[-1]
    cs = jnp.cumsum(a, axis=-1)
    diff = cs[..., :, None] - cs[..., None, :]
    mask = jnp.tril(jnp.ones((T, T), dtype=bool))
    return jnp.where(mask, diff, -jnp.inf)


def ssd_scan(xdt, da, bm, cm, init, want_y):
    b, l, g, r, p = xdt.shape
    nc = l // SSD_CHUNK
    xdt = xdt.reshape(b, nc, SSD_CHUNK, g, r, p)
    bc = bm.reshape(b, nc, SSD_CHUNK, g, -1)
    a = da.reshape(b, nc, SSD_CHUNK, g, r).transpose(0, 3, 4, 1, 2)
    a_cs = jnp.cumsum(a, axis=-1)
    decay_to_end = jnp.exp(a_cs[..., -1:] - a_cs)
    states = jnp.einsum('bcsgn,bgrcs,bcsgrp->bcgrpn', bc, decay_to_end, xdt)
    chunk_a = jnp.pad(a_cs[..., -1], ((0, 0), (0, 0), (0, 0), (1, 0)))
    states_all = jnp.concatenate([init[:, None], states], axis=1)
    carried = jnp.einsum('bgrzc,bcgrpn->bzgrpn', jnp.exp(segsum(chunk_a)), states_all)
    final = carried[:, -1]
    if not want_y:
        return final
    cc = cm.reshape(b, nc, SSD_CHUNK, g, -1)
    cb = jnp.einsum('bclgn,bcsgn->bgcls', cc, bc)
    y_diag = jnp.einsum('bgcls,bgrcls,bcsgrp->bclgrp', cb, jnp.exp(segsum(a)), xdt)
    y_off = jnp.einsum('bclgn,bcgrpn,bgrcl->bclgrp', cc, carried[:, :-1], jnp.exp(a_cs))
    y = (y_diag + y_off).reshape(b, l, g, r, p)
    return y, final


def ssd_branch(h, init_f, init_b, grid, lp, want_y):
    b, L, _ = h.shape
    f32 = jnp.float32
    w_in = lp['w_in']
    o0 = HY_PROJ
    o1 = o0 + SSD_XBC
    o2 = o1 + SSD_DT
    xbc = jax.nn.silu(centred_dwconv(h @ w_in[:, o0:o1], lp['ssd_conv_w'], lp['ssd_conv_b'], grid)).astype(f32)
    gn = SSD_GROUPS * SSD_STATE
    xs = xbc[..., :SSD_W].reshape(b, L, SSD_GROUPS, SSD_HPG, SSD_HEADDIM)
    bm = xbc[..., SSD_W:SSD_W + gn].reshape(b, L, SSD_GROUPS, SSD_STATE)
    cm = xbc[..., SSD_W + gn:].reshape(b, L, SSD_GROUPS, SSD_STATE)
    dt = jax.nn.softplus((h @ w_in[:, o1:o2]).astype(f32).reshape(b, L, 2, SSD_HEADS) + lp['dt_bias'])
    dt = dt.reshape(b, L, 2, SSD_GROUPS, SSD_HPG)
    a = (-jnp.exp(lp['a_log'].astype(f32))).reshape(2, SSD_GROUPS, SSD_HPG)

    def run(d, init, flip):
        dt_d = dt[:, :, d]
        seqs = (xs * dt_d[..., None], dt_d * a[d], bm, cm)
        if flip:
            seqs = tuple(s[:, ::-1] for s in seqs)
        return ssd_scan(seqs[0], seqs[1], seqs[2], seqs[3], init, want_y)

    if not want_y:
        return run(0, init_f, False), run(1, init_b, True)
    y_f, s_f = run(0, init_f, False)
    y_b, s_b = run(1, init_b, True)
    y = y_f + y_b[:, ::-1] + lp['ssd_d'].reshape(SSD_GROUPS, SSD_HPG)[..., None] * xs
    zg = jax.nn.silu((h @ w_in[:, o2:]).astype(f32))
    y = (y.reshape(b, L, SSD_W) * zg).reshape(b, L, SSD_GROUPS, SSD_W // SSD_GROUPS)
    y = rmsnorm(y, lp['ssd_norm_w'].reshape(SSD_GROUPS, -1)).reshape(b, L, SSD_W)
    return y.astype(h.dtype), s_f, s_b


def token_mixer(h, init_f, init_b, grid, lp):
    b, L, _ = h.shape
    u = centred_dwconv(h @ lp['w_in'][:, :HY_PROJ], lp['hy_conv_w'], lp['hy_conv_b'], grid).astype(jnp.float32)
    v, *gates = jnp.split(u, HY_ORDER + 1, axis=-1)
    kf = hyena_kernel_fft(L, lp['filt_w1'], lp['filt_b1'], lp['filt_freq'], lp['filt_w2'], lp['filt_b2'], lp['filt_w3'])
    z = v
    for o, gate in enumerate(gates):
        z = gate * (fft_conv(z, kf[:, o]) + z * lp['hy_bias'][o])
    y_hy = rmsnorm(z.reshape(b, L, HY_GROUPS, HY_W // HY_GROUPS), lp['hy_norm_w'].reshape(HY_GROUPS, -1))
    y_hy = y_hy.reshape(b, L, HY_W).astype(h.dtype)
    y_ssd, s_f, s_b = ssd_branch(h, init_f, init_b, grid, lp, True)
    out = jnp.concatenate([y_hy, y_ssd], axis=-1) @ lp['w_out']
    return out, s_f, s_b


def sqrelu_mlp(h, w1, w2):
    return jnp.square(jax.nn.relu(h @ w1)) @ w2


def setup_inputs(seed: int = 0) -> dict:
    key = jax.random.key(seed)
    ks = jax.random.split(key, 32)

    def nrm(k, shape, scale):
        return scale * jax.random.normal(k, shape, jnp.float32)

    D = D_MODEL
    dt0 = jnp.exp(jax.random.uniform(ks[20], (DEPTH, 2, SSD_HEADS), jnp.float32, math.log(1e-3), math.log(1e-1)))
    return {
        'x': nrm(ks[0], (BATCH, SEQ, D), 1.0),
        'c': nrm(ks[1], (BATCH, D), 1.0),
        'ctx': nrm(ks[2], (BATCH, CTX_LEN, D), 1.0),
        'c_ctx': nrm(ks[3], (D,), 1.0),
        'w_ada': nrm(ks[4], (DEPTH, D, N_MOD * D), 0.5 * D ** -0.5),
        'b_ada': nrm(ks[5], (DEPTH, N_MOD * D), 0.02),
        'norm1_w': 1.0 + nrm(ks[6], (DEPTH, D), 0.05),
        'w_in': nrm(ks[7], (DEPTH, D, PROJ_W), D ** -0.5),
        'hy_conv_w': nrm(ks[8], (DEPTH, HY_CONV, HY_PROJ), HY_CONV ** -0.5),
        'hy_conv_b': nrm(ks[9], (DEPTH, HY_PROJ), 0.02),
        'filt_w1': nrm(ks[10], (DEPTH, HY_POS_EMB, HY_FILT_H), HY_POS_EMB ** -0.5),
        'filt_b1': nrm(ks[11], (DEPTH, HY_FILT_H), 0.1),
        'filt_freq': 1.0 + nrm(ks[12], (DEPTH, HY_FILT_H), 0.1),
        'filt_w2': nrm(ks[13], (DEPTH, HY_FILT_H, HY_FILT_H), HY_FILT_H ** -0.5),
        'filt_b2': nrm(ks[14], (DEPTH, HY_FILT_H), 0.1),
        'filt_w3': nrm(ks[15], (DEPTH, HY_FILT_H, HY_ORDER * 2 * HY_W), HY_FILT_H ** -0.5),
        'hy_bias': nrm(ks[16], (DEPTH, HY_ORDER, HY_W), 0.1),
        'hy_norm_w': 1.0 + nrm(ks[17], (DEPTH, HY_W), 0.05),
        'ssd_conv_w': nrm(ks[18], (DEPTH, SSD_CONV, SSD_XBC), SSD_CONV ** -0.5),
        'ssd_conv_b': nrm(ks[19], (DEPTH, SSD_XBC), 0.02),
        'dt_bias': dt0 + jnp.log(-jnp.expm1(-dt0)),
        'a_log': jnp.log(jax.random.uniform(ks[21], (DEPTH, 2, SSD_HEADS), jnp.float32, 1.0, 16.0)),
        'ssd_d': 1.0 + nrm(ks[22], (DEPTH, SSD_HEADS), 0.05),
        'ssd_norm_w': 1.0 + nrm(ks[23], (DEPTH, SSD_W), 0.05),
        'w_out': nrm(ks[24], (DEPTH, D_MIX, D), D_MIX ** -0.5),
        'norm2_w': 1.0 + nrm(ks[25], (DEPTH, D), 0.05),
        'w_mlp1': nrm(ks[26], (DEPTH, D, D_FF), D ** -0.5),
        'w_mlp2': nrm(ks[27], (DEPTH, D_FF, D), D_FF ** -0.5),
        'final_norm_w': 1.0 + nrm(ks[28], (D,), 0.05),
    }


def reference(x, c, ctx, c_ctx, w_ada, b_ada, norm1_w, w_in, hy_conv_w, hy_conv_b, filt_w1, filt_b1,
              filt_freq, filt_w2, filt_b2, filt_w3, hy_bias, hy_norm_w, ssd_conv_w, ssd_conv_b, dt_bias,
              a_log, ssd_d, ssd_norm_w, w_out, norm2_w, w_mlp1, w_mlp2, final_norm_w):
    rows = x.shape[1] // GRID_W
    grid = (rows, GRID_W)
    zero_state = jnp.zeros((x.shape[0], SSD_GROUPS, SSD_HPG, SSD_HEADDIM, SSD_STATE), jnp.float32)
    h_ctx = ctx
    for i in range(DEPTH):
        lp = dict(w_in=w_in[i], hy_conv_w=hy_conv_w[i], hy_conv_b=hy_conv_b[i], filt_w1=filt_w1[i],
                  filt_b1=filt_b1[i], filt_freq=filt_freq[i], filt_w2=filt_w2[i], filt_b2=filt_b2[i],
                  filt_w3=filt_w3[i], hy_bias=hy_bias[i], hy_norm_w=hy_norm_w[i], ssd_conv_w=ssd_conv_w[i],
                  ssd_conv_b=ssd_conv_b[i], dt_bias=dt_bias[i], a_log=a_log[i], ssd_d=ssd_d[i],
                  ssd_norm_w=ssd_norm_w[i], w_out=w_out[i])
        mod = (jax.nn.silu(c) @ w_ada[i] + b_ada[i])[:, None, :]
        mod_c = jax.nn.silu(c_ctx) @ w_ada[i] + b_ada[i]
        sh1, sc1, g1, sh2, sc2, g2 = jnp.split(mod, N_MOD, axis=-1)
        csh1, csc1, cg1, csh2, csc2, cg2 = jnp.split(mod_c, N_MOD, axis=-1)
        hc = rmsnorm(h_ctx, norm1_w[i]) * (1.0 + csc1) + csh1
        if i < DEPTH - 1:
            out_c, s_f, s_b = token_mixer(hc, zero_state, zero_state, None, lp)
            h_ctx = h_ctx + cg1 * out_c
            hc2 = rmsnorm(h_ctx, norm2_w[i]) * (1.0 + csc2) + csh2
            h_ctx = h_ctx + cg2 * sqrelu_mlp(hc2, w_mlp1[i], w_mlp2[i])
        else:
            s_f, s_b = ssd_branch(hc, zero_state, zero_state, None, lp, False)
        hl = rmsnorm(x, norm1_w[i]) * (1.0 + sc1) + sh1
        out_l, _, _ = token_mixer(hl, s_f, s_b, grid, lp)
        x = x + g1 * out_l
        hl2 = rmsnorm(x, norm2_w[i]) * (1.0 + sc2) + sh2
        x = x + g2 * sqrelu_mlp(hl2, w_mlp1[i], w_mlp2[i])
    return rmsnorm(x, final_norm_w)
```

```cpp
#include <hip/hip_runtime.h>
#include <cstdio>
#include <cstdint>
namespace pg8 {
#define PG8_LAS __attribute__((address_space(3)))
typedef unsigned short bf16_t;
typedef short bf16x8 __attribute__((ext_vector_type(8)));
typedef float f32x4 __attribute__((ext_vector_type(4)));
typedef unsigned u32x4 __attribute__((ext_vector_type(4)));
constexpr int BM = 256, BK = 64, HALF = 128, HTB = HALF * BK * 2  , STAGE_BYTES = 8 * HTB, NXCD = 8, WGM = 8;

__host__ __device__ __forceinline__ int lds_byte(int r, int c) { const int st = (r >> 4) * 2 + (c >> 5), rr = r & 15, cc = c & 31, ob = rr * 64 + cc * 2; return st * 1024 + (ob ^ (((ob >> 9) & 1) << 5)); }
__host__ __device__ __forceinline__ void stage_rc(int b, int& R, int& C) { const int st = b / 1024, sb = b % 1024, swz = sb ^ (((sb >> 9) & 1) << 5); R = (st >> 1) * 16 + swz / 64; C = (st & 1) * 32 + (swz % 64) / 2; }
__host__ __device__ __forceinline__ int perm32(int rho) { const int n = rho >> 4, i = rho & 15; return 8 * (i >> 2) + 4 * n + (i & 3); }

struct Unit { int pm, pn, kb; };
struct Gemm { const bf16_t* A; const bf16_t* Bt; int M, N, K, ld, lda; };

struct StaticOrder {
    int nM, nN, nwg, G, c, wgm;
    __host__ __device__ void init(int M, int N, int G_, int c_, int wgm_ = WGM) { nM = M / BM; nN = N / BM; nwg = nM * nN; G = G_; c = c_; wgm = wgm_; }
    __host__ __device__ bool next(int i, Unit& u) const {
        const long L = (long)i * G + c; if (L >= nwg) return false;
        int wgid = (int)L; { const int q = nwg / NXCD, r = nwg % NXCD, xcd = wgid % NXCD, off = wgid / NXCD; wgid = (xcd < r ? xcd * (q + 1) : r * (q + 1) + (xcd - r) * q) + off; }
        const int nig = wgm * nN, gid = wgid / nig, fm = gid * wgm, gsz = (nM - fm) < wgm ? (nM - fm) : wgm;
        u.pm = fm + ((wgid % nig) % gsz); u.pn = (wgid % nig) / gsz; u.kb = 0; return true;
    }
    __device__ __forceinline__ void a_ready(const Unit&) const {}
    __device__ __forceinline__ void done(const Unit&) const {}
};

struct SplitKOrder {
    int pm0, nN, nS, nwg, G, c, kbytes;
    __host__ __device__ void init(int pm0_, int nMs, int N, int nS_, int K, int G_, int c_) { pm0 = pm0_; nN = N / BM; nS = nS_; nwg = nMs * nN * nS; G = G_; c = c_; kbytes = K * 2; }
    __host__ __device__ bool next(int i, Unit& u) const { const long L = (long)i * G + c; if (L >= nwg) return false; const int w = (int)L; u.kb = (w % nS) * kbytes; u.pn = (w / nS) % nN; u.pm = pm0 + w / (nS * nN); return true; }
    __device__ __forceinline__ void a_ready(const Unit&) const {}
    __device__ __forceinline__ void done(const Unit&) const {}
};

__device__ __forceinline__ unsigned cvt_pk_bf16(float lo, float hi) { unsigned r; asm volatile("v_cvt_pk_bf16_f32 %0, %1, %2" : "=v"(r) : "v"(lo), "v"(hi)); return r; }
typedef unsigned u32x2 __attribute__((ext_vector_type(2)));
struct EpiInProj {
    static constexpr bool PERM = true, AFTER_DRAIN = false;
    bf16_t* UTl; bf16_t* UTc; bf16_t* XBC; bf16_t* ZG; float* DT;
    __device__ __forceinline__ void operator()(const f32x4 (&acc)[2][2][4][2], const Unit& u, int wr, int wc, int fr, int fq) const {
        const int pn = u.pn, pm = u.pm;
        const int rloc0 = wr * 64 + fr;
        if (pn < 12) {
            bf16_t* base; int L, t0;
            if (pm < 64) { base = UTl + (size_t)(pm >> 4) * 3072 * 4096; L = 4096; t0 = (pm & 15) * 256; }
            else { base = UTc + (size_t)(pm - 64) * 3072 * 256; L = 256; t0 = 0; }
            const int odd = fr & 1;
#pragma unroll
            for (int ai = 0; ai < 2; ++ai)
#pragma unroll
                for (int m = 0; m < 4; ++m) { const int t = t0 + ai * HALF + m * 16 + rloc0;
#pragma unroll
                    for (int bj = 0; bj < 2; ++bj)
#pragma unroll
                        for (int n = 0; n < 2; ++n) { const int c = pn * BM + bj * HALF + wc * 32 + fq * 8 + n * 4; const f32x4 v = acc[ai][bj][m][n];
#pragma unroll
                            for (int pr = 0; pr < 2; ++pr) { const float va = pr ? v[2] : v[0], vb = pr ? v[3] : v[1];
                                const float send = odd ? va : vb; const float recv = __builtin_bit_cast(float, __builtin_amdgcn_mov_dpp(__builtin_bit_cast(int, send), 0xB1, 0xF, 0xF, true));
                                const float lo = odd ? recv : va, hi = odd ? vb : recv; const int ch = c + 2 * pr + odd; const int tk = t - odd;
                                *(unsigned*)(base + (size_t)ch * L + tk) = cvt_pk_bf16(lo, hi); } } }
        } else if (pn < 22) {
            bf16_t* O; int ldc, colt;
            if (pn < 18) { O = XBC; ldc = 1536; colt = (pn - 12) * BM; } else { O = ZG; ldc = 1024; colt = (pn - 18) * BM; }
            const int col0 = colt + wc * 32 + 8 * fq;
#pragma unroll
            for (int ai = 0; ai < 2; ++ai)
#pragma unroll
                for (int m = 0; m < 4; ++m) { bf16_t* rowp = O + (size_t)(pm * BM + ai * HALF + m * 16 + rloc0) * ldc + col0;
#pragma unroll
                    for (int bj = 0; bj < 2; ++bj) { const f32x4 v0 = acc[ai][bj][m][0], v1 = acc[ai][bj][m][1];
                        u32x4 w; w.x = cvt_pk_bf16(v0[0], v0[1]); w.y = cvt_pk_bf16(v0[2], v0[3]); w.z = cvt_pk_bf16(v1[0], v1[1]); w.w = cvt_pk_bf16(v1[2], v1[3]);
                        *(u32x4*)(rowp + bj * HALF) = w; } }
        } else {
            if (wc == 0) {
#pragma unroll
                for (int ai = 0; ai < 2; ++ai)
#pragma unroll
                    for (int m = 0; m < 4; ++m) { float* rowp = DT + (size_t)(pm * BM + ai * HALF + m * 16 + rloc0) * 32 + 8 * fq;
                        *(f32x4*)rowp = acc[ai][0][m][0]; *(f32x4*)(rowp + 4) = acc[ai][0][m][1]; }
            }
        }
    }
};
struct EpiResid {
    static constexpr bool PERM = true, AFTER_DRAIN = false;
    bf16_t* X; const float* mod; int goff; float s;
    __device__ __forceinline__ void operator()(const f32x4 (&acc)[2][2][4][2], const Unit& u, int wr, int wc, int fr, int fq) const {
        const int brow = u.pm < 64 ? (u.pm >> 4) : 4;
        const int row0 = u.pm * BM + wr * 64 + fr, col0 = u.pn * BM + wc * 32 + 8 * fq;
        const float* g = mod + brow * 12288 + goff + col0;
        f32x4 gv[2][2];
#pragma unroll
        for (int bj = 0; bj < 2; ++bj)
#pragma unroll
            for (int n = 0; n < 2; ++n) gv[bj][n] = *(const f32x4*)(g + bj * HALF + 4 * n) * s;
#pragma unroll
        for (int ai = 0; ai < 2; ++ai)
#pragma unroll
            for (int m = 0; m < 4; ++m) { bf16_t* rowp = X + (size_t)(row0 + ai * HALF + m * 16) * 2048 + col0;
#pragma unroll
                for (int bj = 0; bj < 2; ++bj) { const u32x4 o = *(const u32x4*)(rowp + bj * HALF);
                    f32x4 x0 = {__builtin_bit_cast(float, o.x << 16), __builtin_bit_cast(float, o.x & 0xffff0000u), __builtin_bit_cast(float, o.y << 16), __builtin_bit_cast(float, o.y & 0xffff0000u)};
                    f32x4 x1 = {__builtin_bit_cast(float, o.z << 16), __builtin_bit_cast(float, o.z & 0xffff0000u), __builtin_bit_cast(float, o.w << 16), __builtin_bit_cast(float, o.w & 0xffff0000u)};
                    x0 += gv[bj][0] * acc[ai][bj][m][0]; x1 += gv[bj][1] * acc[ai][bj][m][1];
                    u32x4 w; w.x = cvt_pk_bf16(x0[0], x0[1]); w.y = cvt_pk_bf16(x0[2], x0[3]); w.z = cvt_pk_bf16(x1[0], x1[1]); w.w = cvt_pk_bf16(x1[2], x1[3]);
                    *(u32x4*)(rowp + bj * HALF) = w; }
                asm volatile("" ::: "memory"); }
    }
};
struct EpiPartial {
    static constexpr bool PERM = true, AFTER_DRAIN = false;
    bf16_t* part; int kbytes, row0, nrows;
    __device__ __forceinline__ void operator()(const f32x4 (&acc)[2][2][4][2], const Unit& u, int wr, int wc, int fr, int fq) const {
        const int ks = u.kb / kbytes;
        const int rloc = u.pm * BM - row0 + wr * 64 + fr, col0 = u.pn * BM + wc * 32 + 8 * fq;
        bf16_t* base = part + ((size_t)ks * nrows + rloc) * 2048 + col0;
#pragma unroll
        for (int ai = 0; ai < 2; ++ai)
#pragma unroll
            for (int m = 0; m < 4; ++m) { bf16_t* rowp = base + (size_t)(ai * HALF + m * 16) * 2048;
#pragma unroll
                for (int bj = 0; bj < 2; ++bj) { const f32x4 v0 = acc[ai][bj][m][0], v1 = acc[ai][bj][m][1];
                    u32x4 w; w.x = cvt_pk_bf16(v0[0], v0[1]); w.y = cvt_pk_bf16(v0[2], v0[3]); w.z = cvt_pk_bf16(v1[0], v1[1]); w.w = cvt_pk_bf16(v1[2], v1[3]);
                    *(u32x4*)(rowp + bj * HALF) = w; } }
    }
};
struct EpiSqRelu {
    static constexpr bool PERM = true, AFTER_DRAIN = false;
    bf16_t* O; int ldc;
    __device__ __forceinline__ void operator()(const f32x4 (&acc)[2][2][4][2], const Unit& u, int wr, int wc, int fr, int fq) const {
        const int row0 = u.pm * BM + wr * 64 + fr, col0 = u.pn * BM + wc * 32 + 8 * fq;
#pragma unroll
        for (int ai = 0; ai < 2; ++ai)
#pragma unroll
            for (int m = 0; m < 4; ++m) { bf16_t* rowp = O + (size_t)(row0 + ai * HALF + m * 16) * ldc + col0;
#pragma unroll
                for (int bj = 0; bj < 2; ++bj) { f32x4 v0 = acc[ai][bj][m][0], v1 = acc[ai][bj][m][1];
#pragma unroll
                    for (int j = 0; j < 4; ++j) { const float a = v0[j] > 0.f ? v0[j] : 0.f, b = v1[j] > 0.f ? v1[j] : 0.f; v0[j] = a * a; v1[j] = b * b; }
                    u32x4 w; w.x = cvt_pk_bf16(v0[0], v0[1]); w.y = cvt_pk_bf16(v0[2], v0[3]); w.z = cvt_pk_bf16(v1[0], v1[1]); w.w = cvt_pk_bf16(v1[2], v1[3]);
                    *(u32x4*)(rowp + bj * HALF) = w; } }
    }
};
template <class Epi, class Sched, bool ALIGN_EPI = false, bool SP2 = false>
__device__ __forceinline__ void gemm_phase(PG8_LAS unsigned char* lds, const Gemm g, const Sched& S, const Epi& E) {
    const int tid = threadIdx.x, wid = __builtin_amdgcn_readfirstlane(tid >> 6), lane = tid & 63, wr = wid >> 2, wc = wid & 3, fr = lane & 15, fq = lane >> 4;
    const int K = g.K, nt = K / BK;
    const int lda = g.lda ? g.lda : g.ld;
    unsigned voffA[2], voffB[2];
#pragma unroll
    for (int i = 0; i < 2; ++i) { int R, C; stage_rc(tid * 16 + i * 8192, R, C); const int Rb = Epi::PERM ? ((R & ~31) + perm32(R & 31)) : R;
        voffA[i] = (unsigned)(R * lda + C) * 2u; voffB[i] = (unsigned)(Rb * g.ld + C) * 2u; }
    const size_t kstep = (size_t)(BK * 2);
    const size_t hstep = (size_t)HALF * g.ld * 2;
    const size_t tstep = 2 * hstep;
    const size_t hstepA = (size_t)HALF * lda * 2, tstepA = 2 * hstepA;
    const unsigned ldsw = (unsigned)wid * 1024u;
    const int aoff = lds_byte(wr * 64 + fr, fq * 8), boff = lds_byte(wc * 32 + fr, fq * 8);
#define PG8_SA(b, h) (((b) * 2 + (h)) * HTB)
#define PG8_SB(b, h) ((4 + (b) * 2 + (h)) * HTB)
#define PG8_STAGE(bufoff, gbase, voff) do { _Pragma("unroll") for (int _i = 0; _i < 2; ++_i) \
        __builtin_amdgcn_global_load_lds((const unsigned*)((const char*)(gbase) + (voff)[_i]), (PG8_LAS unsigned*)(lds + (bufoff) + ldsw + _i * 8192), 16, 0, 0); } while (0)
#define PG8_LDA(dst, b, h) do { _Pragma("unroll") for (int m = 0; m < 4; ++m) _Pragma("unroll") for (int k = 0; k < 2; ++k) dst[m][k] = *(const PG8_LAS bf16x8*)(lds + PG8_SA(b, h) + aoff + m * 2048 + k * 1024); } while (0)
#define PG8_LDB(dst, b, h) do { _Pragma("unroll") for (int n = 0; n < 2; ++n) _Pragma("unroll") for (int k = 0; k < 2; ++k) dst[n][k] = *(const PG8_LAS bf16x8*)(lds + PG8_SB(b, h) + boff + n * 2048 + k * 1024); } while (0)
#define PG8_MMA(ai, bj, At, Bt) do { __builtin_amdgcn_s_setprio(1); _Pragma("unroll") for (int m = 0; m < 4; ++m) _Pragma("unroll") for (int n = 0; n < 2; ++n) _Pragma("unroll") for (int k = 0; k < 2; ++k) \
        acc[ai][bj][m][n] = __builtin_amdgcn_mfma_f32_16x16x32_bf16(Bt[n][k], At[m][k], acc[ai][bj][m][n], 0, 0, 0); __builtin_amdgcn_s_setprio(0); } while (0)
#define PG8_WAIT_V(n) asm volatile("s_waitcnt vmcnt(" #n ")" ::: "memory")
#define PG8_WAIT_L(n) asm volatile("s_waitcnt lgkmcnt(" #n ")" ::: "memory")
#define PG8_BAR __builtin_amdgcn_s_barrier()
#define PG8_SCHED __builtin_amdgcn_sched_barrier(0)
    Unit cur, nxt; int ui = 0;
    if (!S.next(0, cur)) return;
    f32x4 acc[2][2][4][2];
#pragma unroll
    for (int a = 0; a < 2; ++a)
#pragma unroll
        for (int b = 0; b < 2; ++b)
#pragma unroll
            for (int m = 0; m < 4; ++m)
#pragma unroll
                for (int n = 0; n < 2; ++n) acc[a][b][m][n] = (f32x4){0.f, 0.f, 0.f, 0.f};
    bf16x8 At[4][2], B0[2][2], B1[2][2];
    const char* cA = (const char*)g.A + (size_t)cur.pm * tstepA + cur.kb; const char* cB = (const char*)g.Bt + (size_t)cur.pn * tstep + cur.kb;
    S.a_ready(cur);
    if constexpr (SP2) {
        PG8_STAGE(PG8_SB(0, 0), cB, voffB); PG8_STAGE(PG8_SB(0, 1), cB + hstep, voffB); PG8_STAGE(PG8_SA(0, 0), cA, voffA); PG8_STAGE(PG8_SA(0, 1), cA + hstepA, voffA);
        if (wr == 1) PG8_BAR;
        PG8_WAIT_V(2); PG8_BAR;
        PG8_STAGE(PG8_SB(1, 0), cB + kstep, voffB); PG8_STAGE(PG8_SA(1, 0), cA + kstep, voffA); PG8_STAGE(PG8_SB(1, 1), cB + hstep + kstep, voffB);
        PG8_WAIT_V(6); PG8_BAR;
    } else {
        PG8_STAGE(PG8_SB(0, 0), cB, voffB); PG8_STAGE(PG8_SA(0, 0), cA, voffA); PG8_STAGE(PG8_SB(0, 1), cB + hstep, voffB); PG8_STAGE(PG8_SA(0, 1), cA + hstepA, voffA);
        if (wr == 1) PG8_BAR;
        PG8_WAIT_V(4); PG8_BAR;
        PG8_STAGE(PG8_SB(1, 0), cB + kstep, voffB); PG8_STAGE(PG8_SA(1, 0), cA + kstep, voffA); PG8_STAGE(PG8_SB(1, 1), cB + hstep + kstep, voffB);
        PG8_WAIT_V(6); PG8_BAR;
    }
    for (;;) {
        const bool has_next = S.next(ui + 1, nxt);
        const char* nA = has_next ? (const char*)g.A + (size_t)nxt.pm * tstepA + nxt.kb : cA; const char* nB = has_next ? (const char*)g.Bt + (size_t)nxt.pn * tstep + nxt.kb : cB;
        for (int t = 0; t < nt; t += 2) {
            const bool last = (t == nt - 2);
            const char* a1 = cA + (size_t)(t + 1) * kstep;
            const char* a2 = last ? nA : cA + (size_t)(t + 2) * kstep; const char* b2 = last ? nB : cB + (size_t)(t + 2) * kstep;
            const char* a3 = a2 + kstep; const char* b3 = b2 + kstep;
            if (last && has_next) S.a_ready(nxt);
            if constexpr (SP2) {
            PG8_LDB(B0, 0, 0); PG8_LDB(B1, 0, 1); PG8_SCHED; PG8_LDA(At, 0, 0); PG8_STAGE(PG8_SA(1, 1), a1 + hstepA, voffA);
            PG8_WAIT_V(8); PG8_WAIT_L(0); PG8_BAR; PG8_MMA(0, 0, At, B0); PG8_MMA(0, 1, At, B1); PG8_BAR; PG8_SCHED;
            PG8_LDA(At, 0, 1); PG8_STAGE(PG8_SB(0, 0), b2, voffB); PG8_STAGE(PG8_SB(0, 1), b2 + hstep, voffB); PG8_STAGE(PG8_SA(0, 0), a2, voffA);
            PG8_WAIT_V(8); PG8_WAIT_L(0); PG8_BAR; PG8_MMA(1, 0, At, B0); PG8_MMA(1, 1, At, B1); PG8_BAR; PG8_SCHED;
            PG8_LDB(B0, 1, 0); PG8_LDB(B1, 1, 1); PG8_SCHED; PG8_LDA(At, 1, 0); PG8_STAGE(PG8_SA(0, 1), a2 + hstepA, voffA);
            PG8_WAIT_V(8); PG8_WAIT_L(0); PG8_BAR; PG8_MMA(0, 0, At, B0); PG8_MMA(0, 1, At, B1); PG8_BAR; PG8_SCHED;
            PG8_LDA(At, 1, 1); PG8_STAGE(PG8_SB(1, 0), b3, voffB); PG8_STAGE(PG8_SB(1, 1), b3 + hstep, voffB); PG8_STAGE(PG8_SA(1, 0), a3, voffA);
            PG8_WAIT_V(8); PG8_WAIT_L(0); PG8_BAR; PG8_MMA(1, 0, At, B0); PG8_MMA(1, 1, At, B1); PG8_BAR; PG8_SCHED;
            } else {
            PG8_LDB(B0, 0, 0); PG8_SCHED; PG8_LDA(At, 0, 0); PG8_STAGE(PG8_SA(1, 1), a1 + hstepA, voffA);
            PG8_WAIT_L(8); PG8_BAR; PG8_WAIT_L(0); PG8_MMA(0, 0, At, B0); PG8_BAR; PG8_SCHED;
            PG8_LDB(B1, 0, 1); PG8_STAGE(PG8_SB(0, 0), b2, voffB);
            PG8_BAR; PG8_WAIT_L(0); PG8_MMA(0, 1, At, B1); PG8_BAR;
            PG8_LDA(At, 0, 1); PG8_STAGE(PG8_SA(0, 0), a2, voffA);
            PG8_BAR; PG8_WAIT_L(0); PG8_MMA(1, 0, At, B0); PG8_BAR; PG8_SCHED;
            PG8_STAGE(PG8_SB(0, 1), b2 + hstep, voffB);
            PG8_WAIT_V(6); PG8_BAR; PG8_MMA(1, 1, At, B1); PG8_BAR;
            PG8_LDB(B0, 1, 0); PG8_SCHED; PG8_LDA(At, 1, 0); PG8_STAGE(PG8_SA(0, 1), a2 + hstepA, voffA);
            PG8_WAIT_L(8); PG8_BAR; PG8_WAIT_L(0); PG8_MMA(0, 0, At, B0); PG8_BAR; PG8_SCHED;
            PG8_LDB(B1, 1, 1); PG8_STAGE(PG8_SB(1, 0), b3, voffB);
            PG8_BAR; PG8_WAIT_L(0); PG8_MMA(0, 1, At, B1); PG8_BAR;
            PG8_LDA(At, 1, 1); PG8_STAGE(PG8_SA(1, 0), a3, voffA);
            PG8_BAR; PG8_WAIT_L(0); PG8_MMA(1, 0, At, B0); PG8_BAR; PG8_SCHED;
            PG8_STAGE(PG8_SB(1, 1), b3 + hstep, voffB);
            PG8_WAIT_V(6); PG8_BAR; PG8_MMA(1, 1, At, B1); PG8_BAR;
            }
        }
        if constexpr (ALIGN_EPI) { if (wr == 0) PG8_BAR; }
        if constexpr (!Epi::AFTER_DRAIN) { E(acc, cur, wr, wc, fr, fq); S.done(cur); }
        if (!has_next) break;
#pragma unroll
        for (int a = 0; a < 2; ++a)
#pragma unroll
            for (int b = 0; b < 2; ++b)
#pragma unroll
                for (int m = 0; m < 4; ++m)
#pragma unroll
                    for (int n = 0; n < 2; ++n) acc[a][b][m][n] = (f32x4){0.f, 0.f, 0.f, 0.f};
        cur = nxt; cA = nA; cB = nB; ++ui;
        if constexpr (ALIGN_EPI) { if (wr == 1) PG8_BAR; }
    }
    PG8_WAIT_V(0);
    if constexpr (!ALIGN_EPI) { if (wr == 0) PG8_BAR; }
    PG8_BAR;
    if constexpr (Epi::AFTER_DRAIN) { E.fused(acc, cur, wr, wc, fr, fq, lds, wid, lane); S.done(cur); }
#undef PG8_SA
#undef PG8_SB
#undef PG8_STAGE
#undef PG8_LDA
#undef PG8_LDB
#undef PG8_MMA
#undef PG8_WAIT_V
#undef PG8_WAIT_L
#undef PG8_BAR
#undef PG8_SCHED
}
}
#define XB_TMO      128
#define XB_XCNT(j)  (256  + 64 * (j))
#define XB_XSUB(j)  (1280 + 64 * (j))
#define XB_XGEN(j)  (2304 + 64 * (j))
#define XB_TOP      3328
#define XB_TOPGEN   3392
#define XCD_BAR_WORDS 3456
#define XB_SPIN_CAP (1u << 18)
#define LAS __attribute__((address_space(3)))

__device__ __forceinline__ unsigned xb_ld(unsigned* p)              { return __hip_atomic_load(p, __ATOMIC_RELAXED, __HIP_MEMORY_SCOPE_AGENT); }
__device__ __forceinline__ unsigned xb_add(unsigned* p, unsigned v) { return __hip_atomic_fetch_add(p, v, __ATOMIC_RELAXED, __HIP_MEMORY_SCOPE_AGENT); }
__device__ __forceinline__ unsigned xb_xcc_id() { return (unsigned)__builtin_amdgcn_s_getreg((3 << 11) | 20) & 0xFu; }
#define XB_SPIN(cond, bar) do { unsigned _sp = 0; while (cond) { __builtin_amdgcn_s_sleep(1); \
    if ((++_sp & 255u) == 0u) { if (xb_ld(&(bar)[XB_TMO])) break; if (_sp > XB_SPIN_CAP) { atomicAdd(&(bar)[XB_TMO], 1u); break; } } } } while (0)

struct XcdBarrier {
    unsigned* bar; unsigned x;
    volatile LAS unsigned* st;
};

__device__ __forceinline__ XcdBarrier xcd_barrier_post(unsigned* bar, volatile LAS unsigned* st) {
    XcdBarrier b; b.bar = bar; b.x = xb_xcc_id(); b.st = st;
    if (threadIdx.x == 0) (void)xb_add(&bar[XB_XCNT(b.x)], 1u);
    return b;
}
__device__ __forceinline__ void xcd_barrier_complete(unsigned* bar, unsigned x, unsigned& nloc, unsigned& nx) {
    const unsigned G = gridDim.x * gridDim.y * gridDim.z;
    unsigned sum, cnt, mine, sp = 0u;
    for (;;) {
        sum = 0u; cnt = 0u; mine = 0u;
#pragma unroll
        for (unsigned j = 0; j < 16; ++j) { const unsigned c = xb_ld(&bar[XB_XCNT(j)]); sum += c; cnt += (c > 0u) ? 1u : 0u; mine = (j == x) ? c : mine; }
        if (sum == G) break;
        __builtin_amdgcn_s_sleep(1);
        if ((++sp & 255u) == 0u) { if (xb_ld(&bar[XB_TMO])) break; if (sp > XB_SPIN_CAP) { atomicAdd(&bar[XB_TMO], 1u); break; } }
    }
    nloc = mine > 0u ? mine : 1u; nx = cnt > 0u ? cnt : 1u;
}

__device__ __forceinline__ void xcd_barrier(const XcdBarrier& b) {
    asm volatile("s_waitcnt vmcnt(0)" ::: "memory");
    __syncthreads();
    if (threadIdx.x == 0) {
        unsigned* bar = b.bar;
        __builtin_amdgcn_s_waitcnt(0);
        unsigned nloc = b.st[0], nx = b.st[1];
        if (nloc == 0u) { xcd_barrier_complete(bar, b.x, nloc, nx); b.st[0] = nloc; b.st[1] = nx; }
        const unsigned old = xb_add(&bar[XB_XSUB(b.x)], 1u);
        const unsigned gen = old / nloc;
        if (old + 1u == (gen + 1u) * nloc) {
            __builtin_amdgcn_fence(__ATOMIC_RELEASE, "agent");
            asm volatile("s_waitcnt vmcnt(0)" ::: "memory");
            const unsigned og = xb_add(&bar[XB_TOP], 1u);
            const unsigned tg = og / nx;
            if (og + 1u == (tg + 1u) * nx) xb_add(&bar[XB_TOPGEN], 1u);
            else XB_SPIN(xb_ld(&bar[XB_TOPGEN]) == tg, bar);
            __builtin_amdgcn_fence(__ATOMIC_ACQUIRE, "agent");
            xb_add(&bar[XB_XGEN(b.x)], 1u);
            asm volatile("s_waitcnt vmcnt(0)" ::: "memory");
        } else {
            XB_SPIN(xb_ld(&bar[XB_XGEN(b.x)]) == gen, bar);
            __builtin_amdgcn_fence(__ATOMIC_ACQUIRE, "agent");
            asm volatile("s_waitcnt vmcnt(0)" ::: "memory");
        }
    }
    __syncthreads();
}
#define GAS __attribute__((address_space(1)))
typedef unsigned short bf16;
typedef unsigned v4u __attribute__((ext_vector_type(4)));
typedef unsigned v2u __attribute__((ext_vector_type(2)));
typedef float f32x4 __attribute__((ext_vector_type(4)));
constexpr int NWAVES = 8, NTHR = 512;
constexpr int D = 2048, NB = 4, SEQ = 4096, CTX = 256, DEPTH = 4;
constexpr int ML = NB * SEQ, MC = NB * CTX, MROWS = ML + MC;
constexpr int HYW = 1024, HYP = 3072, XBCW = 1536, SSDW = 1024, PROJ = 5664, PROJP = 5888, DFF = 8192, NMOD = 12288;
constexpr float EPS = 1e-6f;
constexpr int LDS_BYTES = 155648;

enum { I_X = 0, I_C, I_CTX, I_CCTX, I_WADA, I_BADA, I_N1W, I_WIN, I_HCW, I_HCB, I_FW1, I_FB1, I_FFREQ, I_FW2, I_FB2, I_FW3, I_HBIAS, I_HNW, I_SCW, I_SCB, I_DTB, I_ALOG, I_SSDD, I_SNW, I_WOUT, I_N2W, I_W1, I_W2, I_FNW, N_IN };

constexpr size_t MiB = (size_t)1 << 20;
constexpr size_t WS_CTL = 0, CTL_ZERO_BYTES = 64 * 1024;
constexpr size_t WS_MOD = 1 * MiB;
constexpr size_t WS_HDNL = 2 * MiB;
constexpr size_t WS_HDNC = 6 * MiB;
constexpr size_t WS_DT = 8 * MiB;
constexpr size_t WS_WIN = 16 * MiB;
constexpr size_t WS_WOUT = 108 * MiB;
constexpr size_t WS_W1 = 140 * MiB;
constexpr size_t WS_W2 = 268 * MiB;
constexpr size_t WS_XR = 396 * MiB;
constexpr size_t WS_XN = 532 * MiB;
constexpr size_t WS_Y = 600 * MiB;
constexpr size_t WS_MIX = 668 * MiB;
constexpr size_t WS_UTL = WS_MIX;
constexpr size_t WS_UTC = WS_MIX + 96 * MiB;
constexpr size_t WS_XBC = WS_MIX + 102 * MiB;
constexpr size_t WS_XBCC = WS_MIX + 153 * MiB;
constexpr size_t WS_ZG = WS_MIX + 204 * MiB;
constexpr size_t WS_YF = WS_MIX + 238 * MiB;
constexpr size_t WS_YB = WS_MIX + 306 * MiB;
constexpr size_t WS_ZTL = WS_MIX + 374 * MiB;
constexpr size_t WS_ZTC = WS_MIX + 406 * MiB;
constexpr size_t WS_H = WS_MIX;
constexpr size_t WS_FSCR = WS_MIX + 408 * MiB;
constexpr size_t WS_ZIN = WS_MIX + 440 * MiB;
constexpr size_t WS_FSG = WS_MIX + 456 * MiB;
constexpr size_t WS_INV = WS_MIX + 520 * MiB;
constexpr size_t WS_FW3T = WS_MIX + 521 * MiB;
constexpr size_t WS_END = WS_MIX + 525 * MiB;
constexpr int CW_BAR = 4096;

constexpr int NPH = 38;

struct Params { const float* in[N_IN]; float* out; unsigned char* ws; int ph_lo, ph_hi; };

#define LDS_WAIT() asm volatile("s_waitcnt lgkmcnt(0)" ::: "memory")
#define LDS_BARRIER() do { asm volatile("s_waitcnt lgkmcnt(0)" ::: "memory"); __builtin_amdgcn_s_barrier(); asm volatile("" ::: "memory"); } while (0)
__device__ __forceinline__ float wave_sum(float v) {
#pragma unroll
    for (int o = 1; o < 64; o <<= 1) v += __shfl_xor(v, o);
    return v;
}
__device__ __forceinline__ unsigned f2bf(float f) { unsigned u = __builtin_bit_cast(unsigned, f); return (u + 0x7fffu + ((u >> 16) & 1u)) >> 16; }
typedef float pk2_f2 __attribute__((ext_vector_type(2))); typedef __bf16 pk2_b2 __attribute__((ext_vector_type(2)));
__device__ __forceinline__ unsigned pk2(float lo, float hi) { const pk2_f2 v = {lo, hi}; return __builtin_bit_cast(unsigned, __builtin_convertvector(v, pk2_b2)); }
__device__ __forceinline__ float bflo(unsigned w) { return __builtin_bit_cast(float, w << 16); }
__device__ __forceinline__ float bfhi(unsigned w) { return __builtin_bit_cast(float, w & 0xffff0000u); }
__device__ __forceinline__ float bf2f(bf16 h) { return __builtin_bit_cast(float, (unsigned)h << 16); }
__device__ __forceinline__ float silu_f(float x) { return x * __builtin_amdgcn_rcpf(1.f + __expf(-x)); }
__device__ __forceinline__ float softplus_f(float x) { const float y = __expf(x); return x > 20.f ? x : (x < -5.f ? y * (1.f - 0.5f * y) : __logf(1.f + y)); }

struct Frame { LAS unsigned char* lds; int tid, lane, wave, G, bid; };

__device__ __forceinline__ void transpose_item(const float* W, int K, int N, bf16* WT, int k0, int n0, int drow0, LAS float* scr, int lane) {
#pragma unroll 8
    for (int i = 0; i < 32; ++i) { const int kk = 2 * i + (lane >> 5); scr[kk * 33 + (lane & 31)] = W[(size_t)(k0 + kk) * N + n0 + (lane & 31)]; }
    LDS_WAIT(); asm volatile("" ::: "memory");
    const int c = lane & 7;
#pragma unroll
    for (int j = 0; j < 4; ++j) { const int n = (lane >> 3) + 8 * j; const LAS float* s = scr + (8 * c) * 33 + n;
        v4u o; o.x = pk2(s[0 * 33], s[1 * 33]); o.y = pk2(s[2 * 33], s[3 * 33]); o.z = pk2(s[4 * 33], s[5 * 33]); o.w = pk2(s[6 * 33], s[7 * 33]);
        *(v4u*)(WT + (size_t)(drow0 + n) * K + k0 + 8 * c) = o; }
    LDS_WAIT(); asm volatile("" ::: "memory");
}

__device__ __forceinline__ void prologue_phase(const Params& P, Frame& F) {
    unsigned char* ws = P.ws;
    {
        LAS float* sc = (LAS float*)F.lds;
        LAS float* red = (LAS float*)(F.lds + 40960);
        for (int i = F.tid; i < 5 * 2048; i += NTHR) { const int r = i >> 11, k = i & 2047; const float v = r < 4 ? P.in[I_C][r * 2048 + k] : P.in[I_CCTX][k]; sc[i] = silu_f(v); }
        __syncthreads();
        float* MOD = (float*)(ws + WS_MOD);
        const int kq = F.tid >> 4, cq = F.tid & 15;
        for (int it = F.bid; it < 4 * 192; it += F.G) {
            const int l = it / 192, cb = it % 192;
            const float* wp = P.in[I_WADA] + (size_t)l * 2048 * NMOD + 64 * cb + 4 * cq;
            f32x4 a0 = {0.f, 0.f, 0.f, 0.f}, a1 = a0, a2 = a0, a3 = a0, a4 = a0;
#pragma unroll 4
            for (int k = kq; k < 2048; k += 32) { const f32x4 w = *(const f32x4*)(wp + (size_t)k * NMOD);
                a0 += w * sc[k]; a1 += w * sc[2048 + k]; a2 += w * sc[4096 + k]; a3 += w * sc[6144 + k]; a4 += w * sc[8192 + k]; }
            LAS f32x4* rp = (LAS f32x4*)red + (kq * 5) * 16 + cq;
            rp[0] = a0; rp[16] = a1; rp[32] = a2; rp[48] = a3; rp[64] = a4;
            __syncthreads();
            if (F.tid < 320) { const int r = F.tid >> 6, col = F.tid & 63; float s = 0.f;
#pragma unroll 8
                for (int q = 0; q < 32; ++q) s += red[(q * 5 + r) * 64 + col];
                MOD[(size_t)(l * 5 + r) * NMOD + 64 * cb + col] = s + P.in[I_BADA][(size_t)l * NMOD + 64 * cb + col]; }
            __syncthreads();
        }
    }
    __syncthreads();
    const int gw = F.bid * NWAVES + F.wave, NGW = F.G * NWAVES;
    {
        LAS float* scr = (LAS float*)(F.lds + F.wave * 16384);
        bf16* Win_t = (bf16*)(ws + WS_WIN); bf16* Wout_t = (bf16*)(ws + WS_WOUT); bf16* W1_t = (bf16*)(ws + WS_W1); bf16* W2_t = (bf16*)(ws + WS_W2);
        constexpr int I_IN = 32 * 177, I_OUT = 32 * 64, I_M1 = 32 * 256, I_M2 = 128 * 64, I_LAYER = I_IN + I_OUT + I_M1 + I_M2;
        for (int it = gw; it < DEPTH * I_LAYER; it += NGW) {
            const int l = it / I_LAYER; int r = it % I_LAYER;
            if (r < I_IN) { const int kb = r / 177, nb = r % 177, n0 = 32 * nb; const int dst = n0 < 4608 ? n0 : (n0 < 4640 ? 5632 + (n0 - 4608) : n0 - 32);
                transpose_item(P.in[I_WIN] + (size_t)l * D * PROJ, D, PROJ, Win_t + (size_t)l * PROJP * D, 64 * kb, n0, dst, scr, F.lane); continue; }
            r -= I_IN;
            if (r < I_OUT) { const int kb = r / 64, nb = r % 64; transpose_item(P.in[I_WOUT] + (size_t)l * D * D, D, D, Wout_t + (size_t)l * D * D, 64 * kb, 32 * nb, 32 * nb, scr, F.lane); continue; }
            r -= I_OUT;
            if (r < I_M1) { const int kb = r / 256, nb = r % 256; transpose_item(P.in[I_W1] + (size_t)l * D * DFF, D, DFF, W1_t + (size_t)l * DFF * D, 64 * kb, 32 * nb, 32 * nb, scr, F.lane); continue; }
            r -= I_M1;
            { const int kb = r / 64, nb = r % 64; transpose_item(P.in[I_W2] + (size_t)l * DFF * D, DFF, D, W2_t + (size_t)l * D * DFF, 64 * kb, 32 * nb, 32 * nb, scr, F.lane); }
        }
        const v4u z = {0u, 0u, 0u, 0u};
        for (int i = F.bid * NTHR + F.tid; i < DEPTH * 57344; i += F.G * NTHR) { const int l = i / 57344, o = i % 57344; ((v4u*)(Win_t + ((size_t)l * PROJP + PROJ) * D))[o] = z; }
    }
    {
        bf16* HLh = (bf16*)(ws + WS_HDNL); float* HC = (float*)(ws + WS_HDNC);
        { bf16* FT = (bf16*)(ws + WS_FW3T);
          for (int i = F.bid * NTHR + F.tid; i < DEPTH * 4096 * 64; i += F.G * NTHR) { const int l = i >> 18, col = (i >> 6) & 4095, jj = i & 63; const float v = P.in[I_FW3][((size_t)l * 64 + jj) * 4096 + col];
              const unsigned hi = f2bf(v); FT[i] = (bf16)hi; FT[(size_t)DEPTH * 4096 * 64 + i] = (bf16)f2bf(v - __builtin_bit_cast(float, hi << 16)); } }
        const int j = F.lane;
        for (int w = gw; w < DEPTH * 4352; w += NGW) {
            const int l = w / 4352, tt = w % 4352; const bool lat = tt < 4096; const int t = lat ? tt : tt - 4096, L = lat ? 4096 : 256;
            const float tl = (float)t / (float)(L - 1);
            const float wv = (6.283185307179586f * (float)t) / (float)L;
            const float fi = 1e-4f + (float)(j & 15) * ((15.0f - 1e-4f) / 15.0f);
            const float ang = fi * wv;
            const float feat = (j < 16) ? cosf(ang) : -sinf(ang);
            const float* fw1 = P.in[I_FW1] + (size_t)l * 33 * 64; const float* fw2 = P.in[I_FW2] + (size_t)l * 64 * 64;
            const float fr = P.in[I_FFREQ][l * 64 + j];
            float pre = P.in[I_FB1][l * 64 + j] + tl * fw1[j];
#pragma unroll 8
            for (int i = 0; i < 32; ++i) pre += __shfl(feat, i) * fw1[(1 + i) * 64 + j];
            const float h1 = sinf(fr * pre);
            float pre2 = P.in[I_FB2][l * 64 + j];
#pragma unroll 8
            for (int i = 0; i < 64; ++i) pre2 += __shfl(h1, i) * fw2[i * 64 + j];
            const float h2 = sinf(fr * pre2);
            if (lat) { const unsigned hi = f2bf(h2); const float rem = h2 - __builtin_bit_cast(float, hi << 16);
                HLh[((size_t)l * 4096 + t) * 64 + j] = (bf16)hi; HLh[(size_t)DEPTH * 4096 * 64 + ((size_t)l * 4096 + t) * 64 + j] = (bf16)f2bf(rem); }
            else HC[((size_t)l * 64 + j) * 256 + t] = h2;
        }
    }
}

template <int KIND> __device__ __forceinline__ void norm_phase(const Params& P, Frame& F, int l, int nrows, const float* part, int nsplit, const float* pgate) {
    unsigned char* ws = P.ws;
    bf16* XR = (bf16*)(ws + WS_XR); bf16* XN = (bf16*)(ws + WS_XN); const float* MOD = (const float*)(ws + WS_MOD);
    const int gw = F.bid * NWAVES + F.wave, NGW = F.G * NWAVES;
    const float* nw = (KIND == 0) ? P.in[I_N1W] + l * D : (KIND == 1 ? P.in[I_N2W] + l * D : P.in[I_FNW]);
    for (int row = gw; row < nrows; row += NGW) {
        float v[4][8]; float ss = 0.f; bool wr_xr = false;
        if (KIND == 0 && l == 0) {
            const float* src = row < ML ? P.in[I_X] + (size_t)row * D : P.in[I_CTX] + (size_t)(row - ML) * D; wr_xr = true;
#pragma unroll
            for (int j = 0; j < 4; ++j) { const f32x4 a = ((const f32x4*)src)[2 * (F.lane + 64 * j)], b = ((const f32x4*)src)[2 * (F.lane + 64 * j) + 1];
                v[j][0] = a.x; v[j][1] = a.y; v[j][2] = a.z; v[j][3] = a.w; v[j][4] = b.x; v[j][5] = b.y; v[j][6] = b.z; v[j][7] = b.w; }
        } else {
#pragma unroll
            for (int j = 0; j < 4; ++j) { const v4u w = ((const v4u*)(XR + (size_t)row * D))[F.lane + 64 * j];
#pragma unroll
                for (int e = 0; e < 4; ++e) { v[j][2 * e] = bflo(w[e]); v[j][2 * e + 1] = bfhi(w[e]); } }
        }
        if (nsplit > 0 && row >= ML) {
            wr_xr = true;
#pragma unroll
            for (int j = 0; j < 4; ++j) { f32x4 a0 = {0.f, 0.f, 0.f, 0.f}, a1 = a0;
                for (int sp = 0; sp < nsplit; ++sp) { const v4u pw = ((const v4u*)((const bf16*)part + ((size_t)sp * MC + (row - ML)) * D))[F.lane + 64 * j];
                    a0 += (f32x4){bflo(pw.x), bfhi(pw.x), bflo(pw.y), bfhi(pw.y)}; a1 += (f32x4){bflo(pw.z), bfhi(pw.z), bflo(pw.w), bfhi(pw.w)}; }
                const f32x4 g0 = ((const f32x4*)pgate)[2 * (F.lane + 64 * j)], g1 = ((const f32x4*)pgate)[2 * (F.lane + 64 * j) + 1];
                v[j][0] += g0.x * a0.x; v[j][1] += g0.y * a0.y; v[j][2] += g0.z * a0.z; v[j][3] += g0.w * a0.w; v[j][4] += g1.x * a1.x; v[j][5] += g1.y * a1.y; v[j][6] += g1.z * a1.z; v[j][7] += g1.w * a1.w; }
        }
#pragma unroll
        for (int j = 0; j < 4; ++j)
#pragma unroll
            for (int e = 0; e < 8; ++e) ss += v[j][e] * v[j][e];
        if (wr_xr) {
#pragma unroll
            for (int j = 0; j < 4; ++j) { v4u w; w.x = pk2(v[j][0], v[j][1]); w.y = pk2(v[j][2], v[j][3]); w.z = pk2(v[j][4], v[j][5]); w.w = pk2(v[j][6], v[j][7]); ((v4u*)(XR + (size_t)row * D))[F.lane + 64 * j] = w; }
        }
        const float rs = 1.0f / sqrtf(wave_sum(ss) * (1.0f / D) + EPS);
        if (KIND == 2) {
#pragma unroll
            for (int j = 0; j < 4; ++j) { const f32x4 w0 = ((const f32x4*)nw)[2 * (F.lane + 64 * j)], w1 = ((const f32x4*)nw)[2 * (F.lane + 64 * j) + 1];
                f32x4 o0 = {v[j][0] * rs * w0.x, v[j][1] * rs * w0.y, v[j][2] * rs * w0.z, v[j][3] * rs * w0.w}, o1 = {v[j][4] * rs * w1.x, v[j][5] * rs * w1.y, v[j][6] * rs * w1.z, v[j][7] * rs * w1.w};
                ((f32x4*)(P.out + (size_t)row * D))[2 * (F.lane + 64 * j)] = o0; ((f32x4*)(P.out + (size_t)row * D))[2 * (F.lane + 64 * j) + 1] = o1; }
        } else {
            const int brow = row < ML ? (row >> 12) : 4;
            const float* mb = MOD + (size_t)(l * 5 + brow) * NMOD + (KIND == 0 ? 0 : 6144);
#pragma unroll
            for (int j = 0; j < 4; ++j) { float y[8];
#pragma unroll
                for (int h = 0; h < 2; ++h) { const int q = 2 * (F.lane + 64 * j) + h; const f32x4 w = ((const f32x4*)nw)[q], sh = ((const f32x4*)mb)[q], sc = ((const f32x4*)(mb + 2048))[q];
                    y[4 * h + 0] = (v[j][4 * h + 0] * rs * w.x) * (sc.x + 1.0f) + sh.x; y[4 * h + 1] = (v[j][4 * h + 1] * rs * w.y) * (sc.y + 1.0f) + sh.y;
                    y[4 * h + 2] = (v[j][4 * h + 2] * rs * w.z) * (sc.z + 1.0f) + sh.z; y[4 * h + 3] = (v[j][4 * h + 3] * rs * w.w) * (sc.w + 1.0f) + sh.w; }
                v4u o; o.x = pk2(y[0], y[1]); o.y = pk2(y[2], y[3]); o.z = pk2(y[4], y[5]); o.w = pk2(y[6], y[7]); ((v4u*)(XN + (size_t)row * D))[F.lane + 64 * j] = o; }
        }
    }
}

typedef short bf16x8_t __attribute__((ext_vector_type(8)));
__device__ __forceinline__ void dt_phase_part(const Params& P, Frame& F, int l) {
    unsigned char* ws = P.ws;
    const bf16* XN = (const bf16*)(ws + WS_XN); const bf16* Wd = (const bf16*)(ws + WS_WIN) + ((size_t)l * PROJP + 5632) * D; float* DTo = (float*)(ws + WS_DT);
    constexpr int ARS = 2056;
    LAS bf16* At = (LAS bf16*)F.lds; LAS float* red = (LAS float*)(F.lds + 16 * ARS * 2);
    const int lc = F.lane & 15, q4 = F.lane >> 4, w = F.wave;
    bf16x8_t b0v[8], b1v[8];
    { const bf16* bp = Wd + (size_t)lc * D + 256 * w + 8 * q4;
#pragma unroll
      for (int e = 0; e < 8; ++e) { b0v[e] = *(const bf16x8_t*)(bp + 32 * e); b1v[e] = *(const bf16x8_t*)(bp + 16 * D + 32 * e); } }
    v4u tmp[8];
    if (F.bid < MROWS / 16) {
#pragma unroll
        for (int i = 0; i < 8; ++i) { const int q = F.tid + 512 * i; tmp[i] = *(const v4u*)(XN + (size_t)(F.bid * 16 + (q >> 8)) * D + 8 * (q & 255)); } }
    for (int rt = F.bid; rt < MROWS / 16; rt += F.G) {
        __syncthreads();
#pragma unroll
        for (int i = 0; i < 8; ++i) { const int q = F.tid + 512 * i; *(LAS v4u*)(At + (q >> 8) * ARS + 8 * (q & 255)) = tmp[i]; }
        if (rt + F.G < MROWS / 16) {
#pragma unroll
            for (int i = 0; i < 8; ++i) { const int q = F.tid + 512 * i; tmp[i] = *(const v4u*)(XN + (size_t)((rt + F.G) * 16 + (q >> 8)) * D + 8 * (q & 255)); } }
        __syncthreads();
        f32x4 a0 = {0.f, 0.f, 0.f, 0.f}, a1 = a0;
#pragma unroll
        for (int e = 0; e < 8; ++e) { const bf16x8_t a = *(const LAS bf16x8_t*)(At + lc * ARS + 256 * w + 32 * e + 8 * q4);
            a0 = __builtin_amdgcn_mfma_f32_16x16x32_bf16(a, b0v[e], a0, 0, 0, 0); a1 = __builtin_amdgcn_mfma_f32_16x16x32_bf16(a, b1v[e], a1, 0, 0, 0); }
#pragma unroll
        for (int r = 0; r < 4; ++r) { red[w * 512 + (4 * q4 + r) * 32 + lc] = a0[r]; red[w * 512 + (4 * q4 + r) * 32 + 16 + lc] = a1[r]; }
        __syncthreads();
        { float sacc = 0.f;
#pragma unroll
          for (int ww = 0; ww < 8; ++ww) sacc += red[ww * 512 + F.tid];
          DTo[(size_t)(rt * 16) * 32 + F.tid] = sacc; }
    }
    __syncthreads();
}
__device__ __forceinline__ void xbc_conv_phase(const Params& P, Frame& F, int l) {
    unsigned char* ws = P.ws;
    dt_phase_part(P, F, l);
#ifdef REP_DT
    dt_phase_part(P, F, l);
#endif
    const bf16* XBC = (const bf16*)(ws + WS_XBC); bf16* XBCC = (bf16*)(ws + WS_XBCC);
    const float* cw = P.in[I_SCW] + (size_t)l * 3 * XBCW; const float* cb = P.in[I_SCB] + (size_t)l * XBCW;
    if (F.tid < 384) {
        const int ch = F.tid % 192, half = F.tid / 192, c0 = ch * 8;
        float w0[8], w1[8], w2[8], bb[8];
#pragma unroll
        for (int e = 0; e < 8; ++e) { w0[e] = cw[c0 + e]; w1[e] = cw[XBCW + c0 + e]; w2[e] = cw[2 * XBCW + c0 + e]; bb[e] = cb[c0 + e]; }
        const v4u z = {0u, 0u, 0u, 0u};
        for (int it = F.bid; it < MROWS / 68; it += F.G) {
            const int r0 = it * 68 + half * 34;
            v4u prev, cur;
            { const int seqmask = r0 < ML ? 63 : 255, rel = r0 < ML ? r0 : r0 - ML;
              prev = ((rel & seqmask) != 0) ? *(const v4u*)(XBC + (size_t)(r0 - 1) * XBCW + c0) : z; cur = *(const v4u*)(XBC + (size_t)r0 * XBCW + c0); }
#pragma unroll 2
            for (int i = 0; i < 34; ++i) {
                const int row = r0 + i; const int seqmask = row < ML ? 63 : 255, rel = row < ML ? row : row - ML; const bool hn = ((rel & seqmask) != seqmask);
                const v4u nxt = (i < 33 || hn) ? *(const v4u*)(XBC + (size_t)(row + 1 < MROWS ? row + 1 : row) * XBCW + c0) : z;
                const v4u nx = hn ? nxt : z;
                float o[8];
#pragma unroll
                for (int q = 0; q < 4; ++q) {
                    const float ya = bb[2 * q] + w0[2 * q] * bflo(prev[q]) + w1[2 * q] * bflo(cur[q]) + w2[2 * q] * bflo(nx[q]);
                    const float yb = bb[2 * q + 1] + w0[2 * q + 1] * bfhi(prev[q]) + w1[2 * q + 1] * bfhi(cur[q]) + w2[2 * q + 1] * bfhi(nx[q]);
                    o[2 * q] = silu_f(ya); o[2 * q + 1] = silu_f(yb); }
                v4u w; w.x = pk2(o[0], o[1]); w.y = pk2(o[2], o[3]); w.z = pk2(o[4], o[5]); w.w = pk2(o[6], o[7]);
                *(v4u*)(XBCC + (size_t)row * XBCW + c0) = w;
                const bool hp_next = (((rel + 1) & seqmask) != 0);
                prev = hp_next ? cur : z; cur = nxt;
            }
        }
    }
}

__device__ __forceinline__ void ssd_naive_item(const Params& P, Frame& F, int l, int item) {
    unsigned char* ws = P.ws;
    const bf16* XBCC = (const bf16*)(ws + WS_XBCC); const float* DT = (const float*)(ws + WS_DT);
    const int b = item >> 5, h = (item >> 1) & 15, d = item & 1, g = h >> 3;
    float* Yo = (float*)(ws + (d ? WS_YB : WS_YF));
    const float A = -expf(P.in[I_ALOG][l * 32 + d * 16 + h]), dtb = P.in[I_DTB][l * 32 + d * 16 + h];
    LAS float* xs = (LAS float*)F.lds;
    LAS float* Bs = xs + 2048;
    LAS float* Cs = Bs + 4096;
    LAS float* ys = Cs + 4096;
    LAS float* dts = ys + 2048;
    LAS float* das = dts + 32;
    const int p = F.tid >> 3, nq = F.tid & 7;
    float S[16];
#pragma unroll
    for (int j = 0; j < 16; ++j) S[j] = 0.f;
    for (int seg = 0; seg < 2; ++seg) {
        const int base_row = seg == 0 ? ML + b * CTX : b * SEQ, L = seg == 0 ? CTX : SEQ;
        for (int blk = 0; blk < L / 32; ++blk) {
            { const int i = F.tid >> 4, q = F.tid & 15; const int pos = blk * 32 + i; const int t = d ? (L - 1 - pos) : pos; const size_t row = (size_t)(base_row + t);
              const v2u xr = *(const v2u*)(XBCC + row * XBCW + h * 64 + 4 * q);
              xs[i * 64 + 4 * q + 0] = bflo(xr.x); xs[i * 64 + 4 * q + 1] = bfhi(xr.x); xs[i * 64 + 4 * q + 2] = bflo(xr.y); xs[i * 64 + 4 * q + 3] = bfhi(xr.y);
              const v4u br = *(const v4u*)(XBCC + row * XBCW + 1024 + g * 128 + 8 * q); const v4u cr = *(const v4u*)(XBCC + row * XBCW + 1280 + g * 128 + 8 * q);
#pragma unroll
              for (int e = 0; e < 4; ++e) { Bs[i * 128 + 8 * q + 2 * e] = bflo(br[e]); Bs[i * 128 + 8 * q + 2 * e + 1] = bfhi(br[e]); Cs[i * 128 + 8 * q + 2 * e] = bflo(cr[e]); Cs[i * 128 + 8 * q + 2 * e + 1] = bfhi(cr[e]); }
              if (F.tid < 32) { const int pos2 = blk * 32 + F.tid; const int t2 = d ? (L - 1 - pos2) : pos2; const float dt = softplus_f(DT[(size_t)(base_row + t2) * 32 + d * 16 + h] + dtb); dts[F.tid] = dt; das[F.tid] = expf(dt * A); } }
            __syncthreads();
            for (int i = 0; i < 32; ++i) {
                const float dA = das[i], xdt = xs[i * 64 + p] * dts[i]; float acc = 0.f;
#pragma unroll
                for (int j = 0; j < 16; ++j) { S[j] = S[j] * dA + xdt * Bs[i * 128 + nq * 16 + j]; acc += Cs[i * 128 + nq * 16 + j] * S[j]; }
                acc += __shfl_xor(acc, 1); acc += __shfl_xor(acc, 2); acc += __shfl_xor(acc, 4);
                if (nq == 0) ys[i * 64 + p] = acc;
            }
            __syncthreads();
            { const int i = F.tid >> 4, q = F.tid & 15; const int pos = blk * 32 + i; const int t = d ? (L - 1 - pos) : pos; const size_t row = (size_t)(base_row + t);
              *(f32x4*)(Yo + row * SSDW + h * 64 + 4 * q) = *(LAS f32x4*)(ys + i * 64 + 4 * q); }
        }
    }
    __syncthreads();
}

__device__ __forceinline__ float block_sum(Frame& F, LAS float* red, float v) {
    v = wave_sum(v);
    __syncthreads();
    if (F.lane == 0) red[F.wave] = v;
    __syncthreads();
    float s = 0.f;
#pragma unroll
    for (int w = 0; w < NWAVES; ++w) s += red[w];
    return s;
}

__device__ __forceinline__ void hyena_lat_naive_item(const Params& P, Frame& F, int l, int c) {
    unsigned char* ws = P.ws;
    const bf16* UT = (const bf16*)(ws + WS_UTL); bf16* ZT = (bf16*)(ws + WS_ZTL); const float* HL = (const float*)(ws + WS_HDNL) + (size_t)l * 64 * 4096;
    LAS float* kk0 = (LAS float*)F.lds; LAS float* kk1 = kk0 + 8192; LAS float* vb = kk1 + 8192; LAS float* x1b = vb + 4096; LAS float* x2b = x1b + 4096; LAS float* zb = x2b + 4096;
    LAS float* red = zb + 4096; LAS float* fw3s = red + 16;
    if (F.tid < 256) { const int q = F.tid >> 6, j = F.tid & 63; fw3s[F.tid] = P.in[I_FW3][((size_t)l * 64 + j) * 4096 + (q >> 1) * 2048 + (q & 1) * 1024 + c]; }
    __syncthreads();
    const float d0 = -3.0701134573253945f, d1 = -15.350567286626973f;
    const float adelta = fabsf(d0 + (float)c * ((d1 - d0) / 1023.0f));
    float s0 = 0.f, s1 = 0.f;
    for (int i = 0; i < 16; ++i) {
        const int idx = F.tid + 512 * i; float h0 = 0.f, h1 = 0.f;
        if (idx != 4096) { const int dir = idx > 4096 ? 1 : 0; const int t = dir ? 8192 - idx : idx;
#pragma unroll 8
            for (int j = 0; j < 64; ++j) { const float hv = HL[(size_t)j * 4096 + t]; h0 += hv * fw3s[dir * 64 + j]; h1 += hv * fw3s[(2 + dir) * 64 + j]; }
            const float win = expf(-((float)t / 4095.0f) * adelta); h0 *= win; h1 *= win; }
        kk0[idx] = h0; kk1[idx] = h1; s0 += fabsf(h0); s1 += fabsf(h1);
    }
    const float inv0 = 1.0f / (block_sum(F, red, s0) + EPS); const float inv1 = 1.0f / (block_sum(F, red, s1) + EPS);
    for (int i = 0; i < 16; ++i) { const int idx = F.tid + 512 * i; kk0[idx] *= inv0; kk1[idx] *= inv1; }
    const float hb0 = P.in[I_HBIAS][l * 2048 + c], hb1 = P.in[I_HBIAS][l * 2048 + 1024 + c];
    float cw[3][3], cbv[3];
#pragma unroll
    for (int o = 0; o < 3; ++o) { cbv[o] = P.in[I_HCB][l * HYP + o * 1024 + c];
#pragma unroll
        for (int k = 0; k < 3; ++k) cw[o][k] = P.in[I_HCW][((size_t)l * 3 + k) * HYP + o * 1024 + c]; }
    for (int b = 0; b < NB; ++b) {
        __syncthreads();
#pragma unroll
        for (int o = 0; o < 3; ++o) { const bf16* src = UT + ((size_t)b * HYP + o * 1024 + c) * SEQ; LAS float* dst = o == 0 ? vb : (o == 1 ? x1b : x2b);
            for (int i = 0; i < 8; ++i) { const int t = F.tid + 512 * i; const float uc = bf2f(src[t]); const float up = (t & 63) != 0 ? bf2f(src[t - 1]) : 0.f; const float un = (t & 63) != 63 ? bf2f(src[t + 1]) : 0.f;
                dst[t] = cbv[o] + cw[o][0] * up + cw[o][1] * uc + cw[o][2] * un; } }
        __syncthreads();
        float y[8];
#pragma unroll
        for (int i = 0; i < 8; ++i) y[i] = 0.f;
        for (int s = 0; s < SEQ; ++s) { const float zs = vb[s];
#pragma unroll
            for (int i = 0; i < 8; ++i) y[i] += kk0[(F.tid + 512 * i - s) & 8191] * zs; }
#pragma unroll
        for (int i = 0; i < 8; ++i) { const int t = F.tid + 512 * i; const float z0 = vb[t]; zb[t] = x1b[t] * (y[i] + z0 * hb0); y[i] = 0.f; }
        __syncthreads();
        for (int s = 0; s < SEQ; ++s) { const float zs = zb[s];
#pragma unroll
            for (int i = 0; i < 8; ++i) y[i] += kk1[(F.tid + 512 * i - s) & 8191] * zs; }
        bf16* dstz = ZT + ((size_t)b * HYW + c) * SEQ;
#pragma unroll
        for (int i = 0; i < 8; ++i) { const int t = F.tid + 512 * i; const float z2 = x2b[t] * (y[i] + zb[t] * hb1); dstz[t] = (bf16)f2bf(z2); }
    }
    __syncthreads();
}

__device__ __forceinline__ void hyena_ctx_item(const Params& P, Frame& F, int l, int c) {
    unsigned char* ws = P.ws;
    const bf16* UT = (const bf16*)(ws + WS_UTC); bf16* ZT = (bf16*)(ws + WS_ZTC); const float* HC = (const float*)(ws + WS_HDNC) + (size_t)l * 64 * 256;
    LAS float* kk0 = (LAS float*)F.lds; LAS float* kk1 = kk0 + 512; LAS float* vb = kk1 + 512; LAS float* x1b = vb + 256; LAS float* x2b = x1b + 256; LAS float* zb = x2b + 256;
    LAS float* red = zb + 256; LAS float* fw3s = red + 16;
    if (F.tid < 256) { const int q = F.tid >> 6, j = F.tid & 63; fw3s[F.tid] = P.in[I_FW3][((size_t)l * 64 + j) * 4096 + (q >> 1) * 2048 + (q & 1) * 1024 + c]; }
    __syncthreads();
    const float d0 = -3.0701134573253945f, d1 = -15.350567286626973f;
    const float adelta = fabsf(d0 + (float)c * ((d1 - d0) / 1023.0f));
    float h0 = 0.f, h1 = 0.f;
    { const int idx = F.tid;
      if (idx != 256) { const int dir = idx > 256 ? 1 : 0; const int t = dir ? 512 - idx : idx;
#pragma unroll 8
          for (int j = 0; j < 64; ++j) { const float hv = HC[j * 256 + t]; h0 += hv * fw3s[dir * 64 + j]; h1 += hv * fw3s[(2 + dir) * 64 + j]; }
          const float win = expf(-((float)t / 255.0f) * adelta); h0 *= win; h1 *= win; } }
    const float inv0 = 1.0f / (block_sum(F, red, fabsf(h0)) + EPS); const float inv1 = 1.0f / (block_sum(F, red, fabsf(h1)) + EPS);
    kk0[F.tid] = h0 * inv0; kk1[F.tid] = h1 * inv1;
    const float hb0 = P.in[I_HBIAS][l * 2048 + c], hb1 = P.in[I_HBIAS][l * 2048 + 1024 + c];
    for (int b = 0; b < NB; ++b) {
        __syncthreads();
        if (F.tid < 256) { const int t = F.tid;
#pragma unroll
            for (int o = 0; o < 3; ++o) { const bf16* src = UT + ((size_t)b * HYP + o * 1024 + c) * CTX; LAS float* dst = o == 0 ? vb : (o == 1 ? x1b : x2b);
                const float uc = bf2f(src[t]); const float up = t != 0 ? bf2f(src[t - 1]) : 0.f; const float un = t != 255 ? bf2f(src[t + 1]) : 0.f;
                dst[t] = P.in[I_HCB][l * HYP + o * 1024 + c] + P.in[I_HCW][((size_t)l * 3 + 0) * HYP + o * 1024 + c] * up + P.in[I_HCW][((size_t)l * 3 + 1) * HYP + o * 1024 + c] * uc + P.in[I_HCW][((size_t)l * 3 + 2) * HYP + o * 1024 + c] * un; } }
        __syncthreads();
        float y = 0.f; const int t = F.tid & 255;
        if (F.tid < 256) { for (int s = 0; s < CTX; ++s) y += kk0[(t - s) & 511] * vb[s]; zb[t] = x1b[t] * (y + vb[t] * hb0); }
        __syncthreads();
        if (F.tid < 256) { y = 0.f; for (int s = 0; s < CTX; ++s) y += kk1[(t - s) & 511] * zb[s]; const float z2 = x2b[t] * (y + zb[t] * hb1); ZT[((size_t)b * HYW + c) * CTX + t] = (bf16)f2bf(z2); }
    }
    __syncthreads();
}

__device__ __forceinline__ void hyena_ctx_item2(const Params& P, Frame& Fin, int l, int c) {
    Frame F = Fin; asm volatile("" : "+v"(F.tid), "+v"(F.lane));
    unsigned char* ws = P.ws;
    const bf16* UT = (const bf16*)(ws + WS_UTC); bf16* ZT = (bf16*)(ws + WS_ZTC); const float* HC = (const float*)(ws + WS_HDNC) + (size_t)l * 64 * 256;
    LAS float* kl0 = (LAS float*)F.lds; LAS float* kl1 = kl0 + 512;
    LAS float* vb = kl1 + 512; LAS float* x1b = vb + 1024; LAS float* x2b = x1b + 1024; LAS float* zb = x2b + 1024;
    LAS float* part = zb + 1024;
    LAS float* red = part + 1024; LAS float* fw3s = red + 16;
    float fw3v = 0.f; if (F.tid < 256) { const int q = F.tid >> 6, j = F.tid & 63; fw3v = P.in[I_FW3][((size_t)l * 64 + j) * 4096 + (q >> 1) * 2048 + (q & 1) * 1024 + c]; }
    float hv[64]; const int idx = F.tid, dir = idx < 255 ? 1 : 0; const int tl = idx == 511 ? 0 : (dir ? 255 - idx : idx - 255);
#pragma unroll
    for (int j = 0; j < 64; ++j) hv[j] = HC[j * 256 + tl];
    unsigned short uraw[2][3][3];
    { const int t = F.tid & 255;
#pragma unroll
      for (int bb = 0; bb < 2; ++bb) { const int b = (F.tid >> 8) + 2 * bb;
#pragma unroll
          for (int o = 0; o < 3; ++o) { const bf16* src = UT + ((size_t)b * HYP + o * 1024 + c) * CTX; uraw[bb][o][0] = src[t]; uraw[bb][o][1] = t != 0 ? src[t - 1] : (unsigned short)0; uraw[bb][o][2] = t != 255 ? src[t + 1] : (unsigned short)0; } } }
    LDS_BARRIER();
    if (F.tid < 256) fw3s[F.tid] = fw3v;
    __syncthreads();
    const float d0 = -3.0701134573253945f, d1v = -15.350567286626973f;
    const float adelta = fabsf(d0 + (float)c * ((d1v - d0) / 1023.0f));
    float h0 = 0.f, h1 = 0.f;
    { if (idx != 511) { const int t = tl;
#pragma unroll
          for (int j = 0; j < 64; ++j) { h0 += hv[j] * fw3s[dir * 64 + j]; h1 += hv[j] * fw3s[(2 + dir) * 64 + j]; }
          const float win = expf(-((float)t / 255.0f) * adelta); h0 *= win; h1 *= win; } }
    const float inv0 = 1.0f / (block_sum(F, red, fabsf(h0)) + EPS); const float inv1 = 1.0f / (block_sum(F, red, fabsf(h1)) + EPS);
    kl0[F.tid] = h0 * inv0; kl1[F.tid] = h1 * inv1;
    const float hb0 = P.in[I_HBIAS][l * 2048 + c], hb1 = P.in[I_HBIAS][l * 2048 + 1024 + c];
    { const int t = F.tid & 255;
#pragma unroll
      for (int bb = 0; bb < 2; ++bb) { const int b = (F.tid >> 8) + 2 * bb;
#pragma unroll
          for (int o = 0; o < 3; ++o) { const bf16* src = UT + ((size_t)b * HYP + o * 1024 + c) * CTX; LAS float* dst = (o == 0 ? vb : (o == 1 ? x1b : x2b)) + b * 256;
              const float uc = bf2f(uraw[bb][o][0]), up = bf2f(uraw[bb][o][1]), un = bf2f(uraw[bb][o][2]); (void)src;
              dst[t] = P.in[I_HCB][l * HYP + o * 1024 + c] + P.in[I_HCW][((size_t)l * 3 + 0) * HYP + o * 1024 + c] * up + P.in[I_HCW][((size_t)l * 3 + 1) * HYP + o * 1024 + c] * uc + P.in[I_HCW][((size_t)l * 3 + 2) * HYP + o * 1024 + c] * un; } } }
    __syncthreads();
    const int b = F.tid >> 7, r = F.tid & 127, tq = r & 63, sh = r >> 6, t0 = 4 * tq;
#pragma unroll
    for (int o = 0; o < 2; ++o) {
        const LAS float* kl = o ? kl1 : kl0; const LAS float* zin = (o ? zb : vb) + b * 256; const LAS float* xg = (o ? x2b : x1b) + b * 256; const float hb = o ? hb1 : hb0;
        float y[4] = {0.f, 0.f, 0.f, 0.f};
#pragma unroll 4
        for (int st = 0; st < 32; ++st) { const int s0 = 128 * sh + 4 * st; const f32x4 v4 = *(const LAS f32x4*)(zin + s0); const LAS float* kb = kl + (t0 - s0 + 252);
            const f32x4 ka = *(const LAS f32x4*)kb, kc = *(const LAS f32x4*)(kb + 4); const float kw[8] = {ka[0], ka[1], ka[2], ka[3], kc[0], kc[1], kc[2], kc[3]};
#pragma unroll
            for (int i = 0; i < 4; ++i)
#pragma unroll
                for (int e = 0; e < 4; ++e) y[i] += v4[e] * kw[i - e + 3]; }
        if (sh) *(LAS f32x4*)(part + (b * 64 + tq) * 4) = (f32x4){y[0], y[1], y[2], y[3]};
        __syncthreads();
        if (!sh) { const f32x4 pp = *(const LAS f32x4*)(part + (b * 64 + tq) * 4); const f32x4 zi = *(const LAS f32x4*)(zin + t0), xv = *(const LAS f32x4*)(xg + t0);
            f32x4 z;
#pragma unroll
            for (int i = 0; i < 4; ++i) z[i] = xv[i] * (y[i] + pp[i] + zi[i] * hb);
            if (o == 0) *(LAS f32x4*)(zb + b * 256 + t0) = z; else { v2u w; w.x = pk2(z[0], z[1]); w.y = pk2(z[2], z[3]); *(v2u*)(ZT + ((size_t)b * HYW + c) * CTX + t0) = w; } }
        __syncthreads();
    }
}

typedef float c32 __attribute__((ext_vector_type(2)));
__device__ __forceinline__ c32 cmul(c32 a, c32 b) { c32 r;
    asm("v_pk_mul_f32 %0, %1, %2 op_sel:[0,0] op_sel_hi:[0,1]\n\tv_pk_fma_f32 %0, %2, %1, %0 op_sel:[1,1,0] op_sel_hi:[0,1,1] neg_lo:[1,0,0]" : "=&v"(r) : "v"(a), "v"(b)); return r; }
__device__ __forceinline__ c32 cmulc(c32 a, c32 b) { c32 r;
    asm("v_pk_mul_f32 %0, %1, %2 op_sel:[0,0] op_sel_hi:[0,1]\n\tv_pk_fma_f32 %0, %2, %1, %0 op_sel:[1,1,0] op_sel_hi:[0,1,1] neg_hi:[0,0,1]" : "=&v"(r) : "v"(a), "v"(b)); return r; }
__device__ __forceinline__ c32 cmul_k(c32 a, c32 k) { c32 r;
    asm("v_pk_mul_f32 %0, %1, %2 op_sel:[0,0] op_sel_hi:[0,1]\n\tv_pk_fma_f32 %0, %2, %1, %0 op_sel:[1,1,0] op_sel_hi:[0,1,1] neg_lo:[1,0,0]" : "=&v"(r) : "v"(a), "s"(k)); return r; }
__device__ __forceinline__ c32 rot_add(c32 a, c32 b) { c32 r; asm("v_pk_add_f32 %0, %1, %2 op_sel:[1,0] op_sel_hi:[0,1] neg_lo:[1,0]" : "=v"(r) : "v"(b), "v"(a)); return r; }
__device__ __forceinline__ c32 rot_sub(c32 a, c32 b) { c32 r; asm("v_pk_add_f32 %0, %1, %2 op_sel:[1,0] op_sel_hi:[0,1] neg_hi:[1,0]" : "=v"(r) : "v"(b), "v"(a)); return r; }
template <bool INV> __device__ __forceinline__ c32 ctw(c32 v, float wr, float wi) { const float s = INV ? -wi : wi;
    if (wr == 0.f) return (c32){-v.y * s, v.x * s};
    return cmul_k(v, (c32){wr, s}); }
template <bool INV> __device__ __forceinline__ void dft4(c32& a, c32& b, c32& c, c32& d) {
    const c32 s02 = a + c, d02 = a - c, s13 = b + d, d13 = b - d;
    a = s02 + s13; c = s02 - s13;
    if (INV) { b = rot_add(d02, d13); d = rot_sub(d02, d13); }
    else { b = rot_sub(d02, d13); d = rot_add(d02, d13); }
}
template <bool INV> __device__ __forceinline__ void dft16(c32 (&x)[16]) {
    constexpr float C1 = 0.92387953251128674f, S1 = 0.38268343236508977f, R2 = 0.70710678118654752f;
#pragma unroll
    for (int a0 = 0; a0 < 4; ++a0) dft4<INV>(x[a0], x[4 + a0], x[8 + a0], x[12 + a0]);
    x[5] = ctw<INV>(x[5], C1, -S1);  x[6] = ctw<INV>(x[6], R2, -R2);   x[7] = ctw<INV>(x[7], S1, -C1);
    x[9] = ctw<INV>(x[9], R2, -R2);  x[10] = ctw<INV>(x[10], 0.f, -1.f); x[11] = ctw<INV>(x[11], -R2, -R2);
    x[13] = ctw<INV>(x[13], S1, -C1); x[14] = ctw<INV>(x[14], -R2, -R2); x[15] = ctw<INV>(x[15], -C1, S1);
#pragma unroll
    for (int d0 = 0; d0 < 4; ++d0) dft4<INV>(x[4 * d0], x[4 * d0 + 1], x[4 * d0 + 2], x[4 * d0 + 3]);
    c32 y[16];
#pragma unroll
    for (int d0 = 0; d0 < 4; ++d0)
#pragma unroll
        for (int d1 = 0; d1 < 4; ++d1) y[d0 + 4 * d1] = x[4 * d0 + d1];
#pragma unroll
    for (int i = 0; i < 16; ++i) x[i] = y[i];
}
template <bool INV> __device__ __forceinline__ void apply_pow(c32 (&r)[16], c32 w) {
    if (INV) w.y = -w.y;
    const c32 p2 = cmul(w, w), p3 = cmul(p2, w), p4 = cmul(p2, p2), p5 = cmul(p4, w), p6 = cmul(p3, p3), p7 = cmul(p4, p3), p8 = cmul(p4, p4);
    r[1] = cmul(r[1], w); r[2] = cmul(r[2], p2); r[3] = cmul(r[3], p3); r[4] = cmul(r[4], p4); r[5] = cmul(r[5], p5); r[6] = cmul(r[6], p6); r[7] = cmul(r[7], p7); r[8] = cmul(r[8], p8);
    r[9] = cmul(r[9], cmul(p8, w)); r[10] = cmul(r[10], cmul(p5, p5)); r[11] = cmul(r[11], cmul(p8, p3)); r[12] = cmul(r[12], cmul(p6, p6));
    r[13] = cmul(r[13], cmul(p8, p5)); r[14] = cmul(r[14], cmul(p7, p7)); r[15] = cmul(r[15], cmul(p8, p7));
}
constexpr int TWROW = 18, TW_OFF = 102400, TW_BYTES = (256 + 16) * TWROW * 8;
template <bool INV> __device__ __forceinline__ void apply_tab(c32 (&r)[16], const LAS c32* row) {
    asm volatile("" : "+v"(row));
    f32x4 q[8];
#pragma unroll
    for (int i = 0; i < 8; ++i) q[i] = *(const LAS f32x4*)(row + 2 * i);
    r[1] = INV ? cmulc(r[1], (c32){q[0].z, q[0].w}) : cmul(r[1], (c32){q[0].z, q[0].w});
#pragma unroll
    for (int i = 1; i < 8; ++i) { const c32 w0 = {q[i].x, q[i].y}, w1 = {q[i].z, q[i].w};
        r[2 * i] = INV ? cmulc(r[2 * i], w0) : cmul(r[2 * i], w0); r[2 * i + 1] = INV ? cmulc(r[2 * i + 1], w1) : cmul(r[2 * i + 1], w1); }
}
__device__ __forceinline__ void fft_tables_build(LAS unsigned char* lds, int tid) {
    LAS c32* tw = (LAS c32*)(lds + TW_OFF);
    for (int i = tid; i < 272 * 16; i += NTHR) { const int row = i >> 4, d = i & 15; float sn, cs;
        if (row < 256) sincospif((float)((row * d) & 4095) * (1.0f / 2048.0f), &sn, &cs); else sincospif((float)(((row - 256) * d) & 255) * (1.0f / 128.0f), &sn, &cs);
        tw[row * TWROW + d] = (c32){cs, -sn}; }
}
#define LAUNDER_C32(v) asm volatile("" : "+v"((v).x), "+v"((v).y))
#define FFT_WAVE_SYNC() asm volatile("s_waitcnt lgkmcnt(0)" ::: "memory")
struct FftThr { int u, d1, lo, g2; c32 wA, wB, wu; const LAS c32* ra; const LAS c32* rb; };
__device__ __forceinline__ c32 w32(int a) {
    constexpr float C[16] = {1.f, 0.98078528040323043f, 0.92387953251128674f, 0.83146961230254524f, 0.70710678118654752f, 0.55557023301960218f, 0.38268343236508977f, 0.19509032201612825f,
                             0.f, -0.19509032201612825f, -0.38268343236508977f, -0.55557023301960218f, -0.70710678118654752f, -0.83146961230254524f, -0.92387953251128674f, -0.98078528040323043f};
    constexpr float S[16] = {0.f, 0.19509032201612825f, 0.38268343236508977f, 0.55557023301960218f, 0.70710678118654752f, 0.83146961230254524f, 0.92387953251128674f, 0.98078528040323043f,
                             1.f, 0.98078528040323043f, 0.92387953251128674f, 0.83146961230254524f, 0.70710678118654752f, 0.55557023301960218f, 0.38268343236508977f, 0.19509032201612825f};
    return (c32){C[a], -S[a]};
}
__device__ __forceinline__ void fft_fwd(c32 (&r)[16], LAS c32* xb, const FftThr& T) {
    dft16<false>(r); apply_tab<false>(r, T.ra);
    { LAS c32* p = xb + T.u + T.d1;
#pragma unroll
      for (int d = 0; d < 16; ++d) p[272 * d] = r[d]; }
    LDS_BARRIER();
    { LAS c32* p = xb + 272 * T.d1 + T.lo;
#pragma unroll
      for (int a = 0; a < 16; ++a) r[a] = p[17 * a];
      dft16<false>(r); apply_tab<false>(r, T.rb);
#pragma unroll
      for (int d = 0; d < 16; ++d) p[17 * d] = r[d]; }
    FFT_WAVE_SYNC();
    { LAS c32* p = xb + 272 * T.d1 + 17 * T.lo;
#pragma unroll
      for (int a = 0; a < 16; ++a) r[a] = p[a]; }
    dft16<false>(r);
}
__device__ __forceinline__ void fft_inv(c32 (&r)[16], LAS c32* xb, const FftThr& T) {
    dft16<true>(r);
    { LAS c32* p = xb + 272 * T.d1 + 17 * T.lo;
#pragma unroll
      for (int a = 0; a < 16; ++a) p[a] = r[a]; }
    FFT_WAVE_SYNC();
    { LAS c32* p = xb + 272 * T.d1 + T.lo;
#pragma unroll
      for (int d = 0; d < 16; ++d) r[d] = p[17 * d];
      apply_tab<true>(r, T.rb); dft16<true>(r);
#pragma unroll
      for (int a = 0; a < 16; ++a) p[17 * a] = r[a]; }
    LDS_BARRIER();
    { LAS c32* p = xb + T.u + T.d1;
#pragma unroll
      for (int d = 0; d < 16; ++d) r[d] = p[272 * d]; }
    apply_tab<true>(r, T.ra); dft16<true>(r);
}
__device__ __forceinline__ FftThr fft_thread_setup(int tid) {
    FftThr T; T.u = tid & 255; T.d1 = T.u >> 4; T.lo = T.u & 15; T.g2 = tid >> 8;
    float s, c;
    sincospif((float)T.u * (1.0f / 2048.0f), &s, &c); T.wA = (c32){c, -s};
    sincospif((float)T.lo * (1.0f / 128.0f), &s, &c); T.wB = (c32){c, -s};
    sincospif((float)T.u * (1.0f / 4096.0f), &s, &c); T.wu = (c32){c, -s};
    return T;
}

__device__ __forceinline__ void hy_conv8_load(const bf16* UT, int c, int o, int pair, int n0, v4u (&raw)[2]) {
#pragma unroll
    for (int bb = 0; bb < 2; ++bb) raw[bb] = *(const v4u*)(UT + ((size_t)(2 * pair + bb) * HYP + o * 1024 + c) * SEQ + n0);
}
__device__ __forceinline__ void hy_conv8_calc(const Params& P, int l, int c, int o, int n0, const v4u (&raw)[2], c32 (&out)[8]) {
    const float cb_ = P.in[I_HCB][l * HYP + o * 1024 + c], w0 = P.in[I_HCW][((size_t)l * 3 + 0) * HYP + o * 1024 + c], w1 = P.in[I_HCW][((size_t)l * 3 + 1) * HYP + o * 1024 + c], w2 = P.in[I_HCW][((size_t)l * 3 + 2) * HYP + o * 1024 + c];
    float val[2][8];
#pragma unroll
    for (int bb = 0; bb < 2; ++bb) {
        float x[8];
#pragma unroll
        for (int e = 0; e < 4; ++e) { x[2 * e] = bflo(raw[bb][e]); x[2 * e + 1] = bfhi(raw[bb][e]); }
        float left = __shfl_up(x[7], 1), right = __shfl_down(x[0], 1);
        if ((n0 & 63) == 0) left = 0.f;
        if ((n0 & 63) == 56) right = 0.f;
#pragma unroll
        for (int e = 0; e < 8; ++e) val[bb][e] = cb_ + w0 * (e ? x[e - 1] : left) + w1 * x[e] + w2 * (e < 7 ? x[e + 1] : right); }
#pragma unroll
    for (int e = 0; e < 8; ++e) out[e] = (c32){val[0][e], val[1][e]};
}
__device__ __forceinline__ void hy_conv8(const Params& P, const bf16* UT, int l, int c, int o, int pair, int n0, c32 (&out)[8]) {
    v4u raw[2]; hy_conv8_load(UT, c, o, pair, n0, raw); hy_conv8_calc(P, l, c, o, n0, raw, out);
}
__device__ __forceinline__ void hy_filt_calc(const float (&hv)[64], const LAS float* fw3s, int t, float adelta, float* FS, float& s0, float& s1) {
    float hq[4] = {0.f, 0.f, 0.f, 0.f};
    const LAS float* fwp = fw3s; asm volatile("" : "+v"(fwp));
#pragma unroll
    for (int j = 0; j < 64; j += 4)
#pragma unroll
        for (int q = 0; q < 4; ++q) { const f32x4 fw = *(const LAS f32x4*)(fwp + q * 64 + j);
#pragma unroll
            for (int e = 0; e < 4; ++e) hq[q] += hv[j + e] * fw[e]; }
    float h0 = hq[0], h1 = hq[1], h2 = hq[2], h3 = hq[3];
    const float win = expf(-((float)t / 4095.0f) * adelta); h0 *= win; h1 *= win; h2 *= win; h3 *= win;
    if (t == 0) { h1 = 0.f; h3 = 0.f; }
    const int tr = (4096 - t) & 4095;
    FS[t] = h0; FS[4096 + tr] = h1; FS[8192 + t] = h2; FS[12288 + tr] = h3;
    s0 += fabsf(h0) + fabsf(h1); s1 += fabsf(h2) + fabsf(h3);
}
__device__ __forceinline__ void hy_filt_calc2(const float (&hv)[64], const LAS float* fw3s, int t, float ad0, float ad1, float* FS, float (&sm)[4]) {
    const float tl = (float)t / 4095.0f; const int tr = (4096 - t) & 4095;
#pragma unroll
    for (int ch = 0; ch < 2; ++ch) {
        float hq[4] = {0.f, 0.f, 0.f, 0.f};
        const LAS float* fwp = fw3s + ch * 256; asm volatile("" : "+v"(fwp));
#pragma unroll
        for (int j = 0; j < 64; j += 4)
#pragma unroll
            for (int q = 0; q < 4; ++q) { const f32x4 fw = *(const LAS f32x4*)(fwp + q * 64 + j);
#pragma unroll
                for (int e = 0; e < 4; ++e) hq[q] += hv[j + e] * fw[e]; }
        const float win = expf(-tl * (ch ? ad1 : ad0));
        float h0 = hq[0] * win, h1 = hq[1] * win, h2 = hq[2] * win, h3 = hq[3] * win;
        if (t == 0) { h1 = 0.f; h3 = 0.f; }
        float* fs = FS + ch * 16384;
        fs[t] = h0; fs[4096 + tr] = h1; fs[8192 + t] = h2; fs[12288 + tr] = h3;
        sm[2 * ch] += fabsf(h0) + fabsf(h1); sm[2 * ch + 1] += fabsf(h2) + fabsf(h3); }
}
__device__ __forceinline__ void filter_table_part(const Params& P, Frame& F, int lf, int it0, int step) {
    unsigned char* ws = P.ws;
    const bf16* HLh = (const bf16*)(ws + WS_HDNL) + (size_t)lf * 4096 * 64; const bf16* HLl = HLh + (size_t)DEPTH * 4096 * 64;
    const bf16* FTh = (const bf16*)(ws + WS_FW3T) + (size_t)lf * 4096 * 64; const bf16* FTl = FTh + (size_t)DEPTH * 4096 * 64;
    float* FSG = (float*)(ws + WS_FSG); float* INV = (float*)(ws + WS_INV);
    LAS float* red = (LAS float*)F.lds;
    const int lc = F.lane & 15, q4 = F.lane >> 4, w = F.wave;
    const float d0 = -3.0701134573253945f, d1v = -15.350567286626973f;
    for (int it = it0; it < 256; it += step) {
        const int c0 = 4 * it;
        bf16x8_t ah[2], al[2];
        { const int col = ((lc & 3) >> 1) * 2048 + (lc & 1) * 1024 + c0 + (lc >> 2);
#pragma unroll
          for (int ks = 0; ks < 2; ++ks) { ah[ks] = *(const bf16x8_t*)(FTh + (size_t)col * 64 + 32 * ks + 8 * q4); al[ks] = *(const bf16x8_t*)(FTl + (size_t)col * 64 + 32 * ks + 8 * q4); } }
        const float ad = fabsf(d0 + (float)(c0 + q4) * ((d1v - d0) / 1023.0f)); float sab0 = 0.f, sab1 = 0.f;
        float* fs = FSG + (size_t)(c0 + q4) * 16384;
#pragma unroll 4
        for (int tt = 0; tt < 32; ++tt) {
            const int t = 512 * w + 16 * tt + lc;
            const bf16* bp = HLh + (size_t)t * 64 + 8 * q4; const bf16* bq = HLl + (size_t)t * 64 + 8 * q4;
            const bf16x8_t bh0 = *(const bf16x8_t*)bp, bh1 = *(const bf16x8_t*)(bp + 32), bl0 = *(const bf16x8_t*)bq, bl1 = *(const bf16x8_t*)(bq + 32);
            const float tl = (float)t / 4095.0f; const int tr = (4096 - t) & 4095;
            f32x4 acc = {0.f, 0.f, 0.f, 0.f};
            acc = __builtin_amdgcn_mfma_f32_16x16x32_bf16(al[0], bh0, acc, 0, 0, 0); acc = __builtin_amdgcn_mfma_f32_16x16x32_bf16(al[1], bh1, acc, 0, 0, 0);
            acc = __builtin_amdgcn_mfma_f32_16x16x32_bf16(ah[0], bl0, acc, 0, 0, 0); acc = __builtin_amdgcn_mfma_f32_16x16x32_bf16(ah[1], bl1, acc, 0, 0, 0);
            acc = __builtin_amdgcn_mfma_f32_16x16x32_bf16(ah[0], bh0, acc, 0, 0, 0); acc = __builtin_amdgcn_mfma_f32_16x16x32_bf16(ah[1], bh1, acc, 0, 0, 0);
            const float win = expf(-tl * ad);
            float h0 = acc[0] * win, h1 = acc[1] * win, h2 = acc[2] * win, h3 = acc[3] * win;
            if (t == 0) { h1 = 0.f; h3 = 0.f; }
            fs[t] = h0; fs[4096 + tr] = h1; fs[8192 + t] = h2; fs[12288 + tr] = h3;
            sab0 += fabsf(h0) + fabsf(h1); sab1 += fabsf(h2) + fabsf(h3);
        }
        __syncthreads();
#pragma unroll
        for (int o = 0; o < 2; ++o) { float v = o ? sab1 : sab0; v += __shfl_xor(v, 1); v += __shfl_xor(v, 2); v += __shfl_xor(v, 4); v += __shfl_xor(v, 8);
            if (lc == 0) red[(w * 4 + q4) * 2 + o] = v; }
        __syncthreads();
        if (F.tid < 8) { float tot = 0.f;
#pragma unroll
            for (int ww = 0; ww < 8; ++ww) tot += red[ww * 8 + F.tid];
            INV[c0 * 2 + F.tid] = 1.0f / (tot + EPS); }
    }
    __syncthreads();
}
__device__ __forceinline__ void hyena_fft_item(const Params& P, Frame& Fin, int l, int c, const FftThr& Tin, int& tw_ok) {
    Frame F = Fin; asm volatile("" : "+v"(F.tid), "+v"(F.lane));
    FftThr T = Tin; asm volatile("" : "+v"(T.u), "+v"(T.d1), "+v"(T.lo), "+v"(T.g2)); LAUNDER_C32(T.wA); LAUNDER_C32(T.wB); LAUNDER_C32(T.wu);
    unsigned char* ws = P.ws;
    const bf16* UT = (const bf16*)(ws + WS_UTL); bf16* ZT = (bf16*)(ws + WS_ZTL);
    const float* FS = (const float*)(ws + WS_FSG) + (size_t)c * 16384;
    const float inv0 = ((const float*)(ws + WS_INV))[2 * c], inv1 = ((const float*)(ws + WS_INV))[2 * c + 1];
    c32* ZIN = (c32*)(ws + WS_ZIN) + (size_t)F.bid * 8192;
    LAS c32* XB0 = (LAS c32*)F.lds; LAS c32* XB1 = XB0 + 4352;
    LAS c32* XG = (LAS c32*)(F.lds + 69632);
    const int g2u = __builtin_amdgcn_readfirstlane(T.g2);
    LAS c32* xb = g2u ? XB1 : XB0;
    const int own = T.u + T.d1;
    const int n0 = 8 * F.tid;
    if (!tw_ok) { fft_tables_build(F.lds, F.tid); tw_ok = 1; }
    T.ra = (const LAS c32*)(F.lds + TW_OFF) + T.u * TWROW; T.rb = (const LAS c32*)(F.lds + TW_OFF) + (256 + T.lo) * TWROW;
    LDS_BARRIER();
    {
    c32 K[16]; v4u graw[2];
    { v4u raw0[2], raw1[2]; hy_conv8_load(UT, c, 0, 0, n0, raw0); hy_conv8_load(UT, c, 0, 1, n0, raw1); hy_conv8_load(UT, c, 1, 0, n0, graw);
      c32 v8[8]; hy_conv8_calc(P, l, c, 0, n0, raw0, v8);
#pragma unroll
      for (int e = 0; e < 8; ++e) ZIN[n0 + e] = v8[e];
      hy_conv8_calc(P, l, c, 0, n0, raw1, v8);
#pragma unroll
      for (int e = 0; e < 8; ++e) ZIN[4096 + n0 + e] = v8[e]; }
    __syncthreads();
#pragma unroll 1
    for (int it = 0; it < 4; ++it) {
        const int o = it >> 1, pair = it & 1;
        if (pair == 0) {
            c32 r[16]; const float* hf = FS + o * 8192 + T.u; c32 wl = T.wu; LAUNDER_C32(wl);
#pragma unroll
            for (int a = 0; a < 16; ++a) { const float lov = hf[256 * a], hiv = hf[4096 + 256 * a]; r[a] = (c32){lov, hiv}; }
            if (g2u) {
#pragma unroll
                for (int a = 0; a < 16; ++a) { const c32 w = cmul_k(wl, w32(a)); const float dd = r[a].x - r[a].y; r[a] = w * dd; } }
            else {
#pragma unroll
                for (int a = 0; a < 16; ++a) r[a] = (c32){r[a].x + r[a].y, 0.f}; }
            fft_fwd(r, xb, T);
            const float sc = (o ? inv1 : inv0) * (1.0f / 8192.0f);
#pragma unroll
            for (int d = 0; d < 16; ++d) K[d] = r[d] * sc;
            __syncthreads();
        }
        const float hb = P.in[I_HBIAS][l * 2048 + o * 1024 + c];
        { c32 g8[8]; hy_conv8_calc(P, l, c, o + 1, n0, graw, g8);
#pragma unroll
          for (int e = 0; e < 8; ++e) XG[n0 + e] = g8[e]; }
        c32* zin = ZIN + pair * 4096 + T.u;
        c32 r[16], zc[16];
        { c32 wl = T.wu; LAUNDER_C32(wl);
#pragma unroll
          for (int a = 0; a < 16; ++a) zc[a] = zin[256 * a];
#pragma unroll
          for (int a = 0; a < 16; ++a) r[a] = zc[a];
          if (g2u) {
#pragma unroll
              for (int a = 0; a < 16; ++a) r[a] = cmul(zc[a], cmul_k(wl, w32(a))); } }
#ifdef REP_FFT
        { c32 rd[16];
#pragma unroll
          for (int a = 0; a < 16; ++a) rd[a] = r[a];
          fft_fwd(rd, xb, T); fft_inv(rd, xb, T);
#pragma unroll
          for (int a = 0; a < 16; ++a) asm volatile("" :: "v"(rd[a].x), "v"(rd[a].y));
          __syncthreads(); }
#endif
        fft_fwd(r, xb, T);
#pragma unroll
        for (int d = 0; d < 16; ++d) r[d] = cmul(r[d], K[d]);
        if (it < 3) {
            const int o2 = (it + 1) >> 1, p2 = (it + 1) & 1;
            hy_conv8_load(UT, c, o2 + 1, p2, n0, graw);
        }
        fft_inv(r, xb, T);
        if (g2u) { c32 wl = T.wu; LAUNDER_C32(wl);
#pragma unroll
            for (int a = 0; a < 16; ++a) { const c32 w = cmul_k(wl, w32(a)); XB1[own + 272 * a] = cmulc(r[a], w); } }
        LDS_BARRIER();
        if (!g2u) {
            bf16* z0p = ZT + ((size_t)(2 * pair) * HYW + c) * SEQ + T.u; bf16* z1p = z0p + (size_t)HYW * SEQ;
#pragma unroll
            for (int a = 0; a < 16; ++a) { const c32 y = r[a] + XB1[own + 272 * a]; const c32 x = XG[T.u + 256 * a]; r[a] = x * (y + zc[a] * hb); }
            if (o == 0) {
#pragma unroll
                for (int a = 0; a < 16; ++a) zin[256 * a] = r[a]; }
            else {
#pragma unroll
                for (int a = 0; a < 16; ++a) { const unsigned pz = pk2(r[a].x, r[a].y); z0p[256 * a] = (bf16)(pz & 0xffffu); z1p[256 * a] = (bf16)(pz >> 16); } } }
        LDS_BARRIER();
    }
    }
}

typedef short bf16x8 __attribute__((ext_vector_type(8)));
constexpr int SRS = 136;
__device__ __forceinline__ float wave_incl_scan(float s) {
#define SCAN_STEP(ctrl, rmask) s += __builtin_bit_cast(float, __builtin_amdgcn_update_dpp(0, __builtin_bit_cast(int, s), ctrl, rmask, 0xf, false))
    SCAN_STEP(0x111, 0xf); SCAN_STEP(0x112, 0xf); SCAN_STEP(0x114, 0xf); SCAN_STEP(0x118, 0xf); SCAN_STEP(0x142, 0xa); SCAN_STEP(0x143, 0xc);
#undef SCAN_STEP
    return s;
}
__device__ __forceinline__ bf16x8 ssd_frag(const LAS bf16* base, int row0, int k0, int lane) { return *(const LAS bf16x8*)(base + (row0 + (lane & 15)) * SRS + k0 + 8 * (lane >> 4)); }
__device__ __forceinline__ bf16x8 ssd_frag_sw(const LAS bf16* base, int row0, int k0, int lane, int sw) { return *(const LAS bf16x8*)(base + (row0 + (lane & 15)) * SRS + ((k0 + 8 * (lane >> 4)) ^ sw)); }
struct SsdPre { v4u c[4], b[4], x[2]; float dt0, dt1; };
__device__ __forceinline__ void ssd_prefetch(SsdPre& R, const bf16* XBCC, const float* DT, int base_row, int L, int k, int d, int h, int g, int tid, int lane) {
    const int j = tid >> 2, q = tid & 3; const int pos = 128 * k + j; const int t = d ? (L - 1 - pos) : pos; const bf16* rp = XBCC + (size_t)(base_row + t) * XBCW;
#pragma unroll
    for (int e = 0; e < 4; ++e) { R.b[e] = *(const v4u*)(rp + 1024 + g * 128 + 32 * q + 8 * e); R.c[e] = *(const v4u*)(rp + 1280 + g * 128 + 32 * q + 8 * e); }
    R.x[0] = *(const v4u*)(rp + h * 64 + 16 * q); R.x[1] = *(const v4u*)(rp + h * 64 + 16 * q + 8);
    if (tid < 64) { const int p0 = 128 * k + 2 * lane; const int t0 = d ? (L - 1 - p0) : p0, t1 = d ? (L - 2 - p0) : p0 + 1;
        R.dt0 = DT[(size_t)(base_row + t0) * 32 + d * 16 + h]; R.dt1 = DT[(size_t)(base_row + t1) * 32 + d * 16 + h]; }
}
__device__ __forceinline__ void ssd_mfma_item(const Params& P, Frame& Fin, int l, int item) {
    Frame F = Fin; asm volatile("" : "+v"(F.tid), "+v"(F.lane));
    unsigned char* ws = P.ws;
    const bf16* XBCC = (const bf16*)(ws + WS_XBCC); const float* DT = (const float*)(ws + WS_DT);
    const int b = item >> 5, h = (item >> 1) & 15, d = item & 1, g = h >> 3;
    bf16* Yo = (bf16*)(ws + (d ? WS_YB : WS_YF));
    const float A = -expf(P.in[I_ALOG][l * 32 + d * 16 + h]), dtb = P.in[I_DTB][l * 32 + d * 16 + h];
    LAS bf16* Cb = (LAS bf16*)F.lds;
    LAS bf16* Bb = Cb + 128 * SRS;
    LAS bf16* BwT = Bb + 128 * SRS;
    LAS bf16* xT = BwT + 128 * SRS;
    LAS bf16* Sb = xT + 64 * SRS;
    LAS float* acs0 = (LAS float*)(Sb + 64 * SRS);
    const int w = F.wave, lane = F.lane, q4 = lane >> 4, lc = lane & 15;
    LDS_BARRIER();
    for (int i = F.tid; i < 64 * SRS / 2; i += NTHR) ((LAS unsigned*)Sb)[i] = 0u;
    f32x4 accs[4];
#pragma unroll
    for (int pt = 0; pt < 4; ++pt) accs[pt] = (f32x4){0.f, 0.f, 0.f, 0.f};
    SsdPre R;
    ssd_prefetch(R, XBCC, DT, ML + b * CTX, CTX, 0, d, h, g, F.tid, lane);
#define SSD_DT_SCAN(buf) do { if (F.tid < 64) { const float dt0 = softplus_f(R.dt0 + dtb), dt1 = softplus_f(R.dt1 + dtb); const float a0 = dt0 * A, a1 = dt1 * A; const float sc_ = wave_incl_scan(a0 + a1); \
        const float ae_ = __shfl(sc_, lane | 7);         \
        LAS float* ab_ = acs0 + 384 * (buf); ab_[2 * lane] = sc_ - a1; ab_[2 * lane + 1] = sc_; ab_[128 + 2 * lane] = dt0; ab_[128 + 2 * lane + 1] = dt1; \
        ab_[256 + 2 * lane] = __expf(ae_ - (sc_ - a1)) * dt0; ab_[256 + 2 * lane + 1] = __expf(ae_ - sc_) * dt1; } } while (0)
    SSD_DT_SCAN(0);
    unsigned ypk[4][2];
#define SSD_Y_STORE(ckk) do { const int sg_ = (ckk) < 2 ? 0 : 1; const int br_ = sg_ ? b * SEQ : ML + b * CTX, L_ = sg_ ? SEQ : CTX, k_ = sg_ ? (ckk) - 2 : (ckk); \
        _Pragma("unroll") for (int r = 0; r < 4; ++r) { const int pos = 128 * k_ + 16 * w + 4 * q4 + r; const int t = d ? (L_ - 1 - pos) : pos; bf16* yp = Yo + (size_t)(br_ + t) * SSDW + h * 64 + lc; \
            _Pragma("unroll") for (int pt = 0; pt < 4; ++pt) yp[16 * pt] = (bf16)((r & 1) ? (ypk[pt][r >> 1] >> 16) : (ypk[pt][r >> 1] & 0xffffu)); } } while (0)
    for (int ck = 0; ck < 34; ++ck) {
        const int seg = ck < 2 ? 0 : 1; const int base_row = seg ? b * SEQ : ML + b * CTX, L = seg ? SEQ : CTX, k = seg ? ck - 2 : ck;
        LAS float* acs = acs0 + 384 * (ck & 1); LAS float* dtv = acs + 128; const LAS float* fjv = acs + 256;
        { const int j = F.tid >> 2, q = F.tid & 3;
#pragma unroll
          for (int e = 0; e < 4; ++e) { *(LAS v4u*)(Cb + j * SRS + 32 * q + 8 * e) = R.c[e]; *(LAS v4u*)(Bb + j * SRS + 32 * q + 8 * e) = R.b[e]; }
#pragma unroll
          for (int e = 0; e < 8; ++e) { const unsigned wv = e < 4 ? R.x[0][e & 3] : R.x[1][e & 3]; xT[(16 * q + 2 * e) * SRS + (j ^ (16 * q))] = (bf16)(wv & 0xffffu); xT[(16 * q + 2 * e + 1) * SRS + (j ^ (16 * q))] = (bf16)(wv >> 16); }
        }
        const SsdPre Rb = R;
        LDS_BARRIER();
        if (ck > 0) SSD_Y_STORE(ck - 1);
        if (ck + 1 < 34) { const int ck2 = ck + 1; const int seg2 = ck2 < 2 ? 0 : 1; ssd_prefetch(R, XBCC, DT, seg2 ? b * SEQ : ML + b * CTX, seg2 ? SEQ : CTX, seg2 ? ck2 - 2 : ck2, d, h, g, F.tid, lane); }
        const float atot = acs[127];
        { const int j = F.tid >> 2, q = F.tid & 3; const float wj = __expf(atot - acs[j]) * dtv[j];
#pragma unroll
          for (int e = 0; e < 4; ++e)
#pragma unroll
              for (int z = 0; z < 4; ++z) { const unsigned wv = Rb.b[e][z]; const int n = 32 * q + 8 * e + 2 * z;
                  const unsigned pw = pk2(bflo(wv) * wj, bfhi(wv) * wj); BwT[n * SRS + (j ^ (16 * q))] = (bf16)(pw & 0xffffu); BwT[(n + 1) * SRS + (j ^ (16 * q))] = (bf16)(pw >> 16); } }
        unsigned mpk[8][2];
        bf16x8 cfr[4];
#pragma unroll
        for (int ks = 0; ks < 4; ++ks) cfr[ks] = ssd_frag(Cb, 16 * w, 32 * ks, lane);
        { const float acs_i = acs[16 * w + lc]; const int irow = 16 * w + lc;
          const float a_w0 = acs[16 * w]; const float Ei = __expf(acs_i - a_w0);
          bf16x8 bfr[2][4];
#pragma unroll
          for (int ks = 0; ks < 4; ++ks) bfr[0][ks] = ssd_frag(Bb, 0, 32 * ks, lane);
#pragma unroll
          for (int jt = 0; jt < 8; ++jt) {
              if (jt <= w) {
                  if (jt + 1 <= w) {
#pragma unroll
                      for (int ks = 0; ks < 4; ++ks) bfr[(jt + 1) & 1][ks] = ssd_frag(Bb, 16 * (jt + 1), 32 * ks, lane); }
                  const f32x4 fj4 = *(const LAS f32x4*)(fjv + 16 * jt + 4 * q4); const float aend = acs[16 * jt + 15];
                  f32x4 gacc = {0.f, 0.f, 0.f, 0.f};
#pragma unroll
                  for (int ks = 0; ks < 4; ++ks) gacc = __builtin_amdgcn_mfma_f32_16x16x32_bf16(bfr[jt & 1][ks], cfr[ks], gacc, 0, 0, 0);
                  float mv[4];
                  if (jt < w) { const float et = Ei * __expf(a_w0 - aend);
#pragma unroll
                      for (int r = 0; r < 4; ++r) mv[r] = gacc[r] * (et * fj4[r]); }
                  else { const f32x4 aj4 = *(const LAS f32x4*)(acs + 16 * jt + 4 * q4), dj4 = *(const LAS f32x4*)(dtv + 16 * jt + 4 * q4);
#pragma unroll
                      for (int r = 0; r < 4; ++r) { const int j = 16 * jt + 4 * q4 + r; const float arg = (j <= irow) ? fminf(acs_i - aj4[r], 0.f) : -200.f; mv[r] = gacc[r] * (__expf(arg) * dj4[r]); } }
                  mpk[jt][0] = pk2(mv[0], mv[1]); mpk[jt][1] = pk2(mv[2], mv[3]);
              } else { mpk[jt][0] = 0u; mpk[jt][1] = 0u; } } }
        f32x4 accy[4];
#pragma unroll
        for (int pt = 0; pt < 4; ++pt) accy[pt] = (f32x4){0.f, 0.f, 0.f, 0.f};
#pragma unroll
        for (int kh = 0; kh < 2; ++kh) { bf16x8 sq[2][4];
#pragma unroll
          for (int ks = 0; ks < 2; ++ks)
#pragma unroll
              for (int pt = 0; pt < 4; ++pt) sq[ks][pt] = ssd_frag(Sb, 16 * pt, 32 * (2 * kh + ks), lane);
          __builtin_amdgcn_sched_barrier(0);
#pragma unroll
          for (int ks = 0; ks < 2; ++ks)
#pragma unroll
              for (int pt = 0; pt < 4; ++pt) accy[pt] = __builtin_amdgcn_mfma_f32_16x16x32_bf16(cfr[2 * kh + ks], sq[ks][pt], accy[pt], 0, 0, 0);
          __builtin_amdgcn_sched_barrier(0); }
        { float ei[4];
#pragma unroll
          for (int r = 0; r < 4; ++r) ei[r] = __expf(acs[16 * w + 4 * q4 + r]);
#pragma unroll
          for (int pt = 0; pt < 4; ++pt)
#pragma unroll
              for (int r = 0; r < 4; ++r) accy[pt][r] *= ei[r]; }
        if (ck + 1 < 34) SSD_DT_SCAN((ck + 1) & 1);
        LDS_BARRIER();
        { LAS bf16* mrow = Bb + (16 * w + lc) * SRS + 4 * q4;
#pragma unroll
          for (int jt = 0; jt < 8; ++jt) { v2u o; o.x = mpk[jt][0]; o.y = mpk[jt][1]; *(LAS v2u*)(mrow + 16 * jt) = o; } }
        LDS_BARRIER();
        { const float ed = __expf(atot);
#pragma unroll
          for (int pt = 0; pt < 4; ++pt) accs[pt] *= ed;
#pragma unroll
          for (int kh = 0; kh < 2; ++kh) { bf16x8 am[2], aw[2], xq[2][4];
#pragma unroll
              for (int ks = 0; ks < 2; ++ks) { am[ks] = ssd_frag(Bb, 16 * w, 32 * (2 * kh + ks), lane); aw[ks] = ssd_frag_sw(BwT, 16 * w, 32 * (2 * kh + ks), lane, 16 * (w >> 1));
#pragma unroll
                  for (int pt = 0; pt < 4; ++pt) xq[ks][pt] = ssd_frag_sw(xT, 16 * pt, 32 * (2 * kh + ks), lane, 16 * pt); }
              __builtin_amdgcn_sched_barrier(0);
#pragma unroll
              for (int ks = 0; ks < 2; ++ks)
#pragma unroll
                  for (int pt = 0; pt < 4; ++pt) { accy[pt] = __builtin_amdgcn_mfma_f32_16x16x32_bf16(am[ks], xq[ks][pt], accy[pt], 0, 0, 0); accs[pt] = __builtin_amdgcn_mfma_f32_16x16x32_bf16(aw[ks], xq[ks][pt], accs[pt], 0, 0, 0); }
              __builtin_amdgcn_sched_barrier(0); }
#pragma unroll
          for (int pt = 0; pt < 4; ++pt) { ypk[pt][0] = pk2(accy[pt][0], accy[pt][1]); ypk[pt][1] = pk2(accy[pt][2], accy[pt][3]); }
#pragma unroll
          for (int pt = 0; pt < 4; ++pt) { v2u o; o.x = pk2(accs[pt][0], accs[pt][1]); o.y = pk2(accs[pt][2], accs[pt][3]); *(LAS v2u*)(Sb + (16 * pt + lc) * SRS + 16 * w + 4 * q4) = o; } }
        LDS_BARRIER();
    }
    SSD_Y_STORE(33);
}

constexpr int CW_QHEAD = 8192;
__device__ __forceinline__ void mixer_phase_v2(const Params& P, Frame& F, int l) {
    const FftThr T = fft_thread_setup(F.tid);
    unsigned* head = (unsigned*)(P.ws + WS_CTL) + CW_QHEAD + 64 * l;
    volatile LAS unsigned* qw = (volatile LAS unsigned*)(F.lds + LDS_BYTES - 32);
    unsigned nxt = 0u; int tw_ok = 0;
    if (F.tid == 0) nxt = __hip_atomic_fetch_add(head, 1u, __ATOMIC_RELAXED, __HIP_MEMORY_SCOPE_AGENT);
    for (;;) {
        LDS_BARRIER();
        if (F.tid == 0) qw[0] = nxt;
        LDS_BARRIER();
        const int it = (int)qw[0];
        if (F.tid == 0 && it < 128 + 1024 + 1024) nxt = __hip_atomic_fetch_add(head, 1u, __ATOMIC_RELAXED, __HIP_MEMORY_SCOPE_AGENT);
        if (it >= 128 + 1024 + (l < DEPTH - 1 ? 1024 : 0)) break;
#ifndef SK_SSDN
        if (it < 128) { tw_ok = 0; ssd_mfma_item(P, F, l, it);
#ifdef REP_SSD
            ssd_mfma_item(P, F, l, it);
#endif
        }
        else
#endif
        if (it < 1152) { hyena_fft_item(P, F, l, it - 128, T, tw_ok);
#ifdef REP_HYL
            hyena_fft_item(P, F, l, it - 128, T, tw_ok);
#endif
        }
#ifndef SK_CTXH
        else { tw_ok = 0; hyena_ctx_item2(P, F, l, it - 1152);
#ifdef REP_HYC
            hyena_ctx_item2(P, F, l, it - 1152);
#endif
        }
#endif
    }
}

__device__ __forceinline__ void finalize_phase(const Params& P, Frame& F, int l) {
    unsigned char* ws = P.ws;
    bf16* Y = (bf16*)(ws + WS_Y);
    const bf16* ZTL = (const bf16*)(ws + WS_ZTL); const bf16* ZTC = (const bf16*)(ws + WS_ZTC);
    const bf16* YF = (const bf16*)(ws + WS_YF); const bf16* YB = (const bf16*)(ws + WS_YB);
    const bf16* XBCC = (const bf16*)(ws + WS_XBCC); const bf16* ZG = (const bf16*)(ws + WS_ZG);
    LAS float* zt = (LAS float*)F.lds;
    LAS float* red = zt + 128 * 65;
    LAS float* rsv = red + 512;
    for (int it = F.bid; it < ((l < DEPTH - 1 ? MROWS : ML) / 64) * 10; it += F.G) {
        const int tile = it / 10, part = it % 10, r0 = tile * 64;
        if (part < 8) {
            const int gh = part; const bf16* src; int L;
            if (r0 < ML) { src = ZTL + ((size_t)(r0 >> 12) * HYW + gh * 128) * SEQ + (r0 & 4095); L = SEQ; } else { const int rr = r0 - ML; src = ZTC + ((size_t)(rr >> 8) * HYW + gh * 128) * CTX + (rr & 255); L = CTX; }
            { const int ch = F.tid >> 2, q = F.tid & 3; const v4u a = *(const v4u*)(src + (size_t)ch * L + 16 * q), b2 = *(const v4u*)(src + (size_t)ch * L + 16 * q + 8);
              LAS float* dz = zt + ch * 65 + 16 * q;
#pragma unroll
              for (int e = 0; e < 4; ++e) { dz[2 * e] = bflo(a[e]); dz[2 * e + 1] = bfhi(a[e]); dz[8 + 2 * e] = bflo(b2[e]); dz[8 + 2 * e + 1] = bfhi(b2[e]); } }
            __syncthreads();
            { const int tt = F.tid & 63, w = F.tid >> 6; float ss = 0.f;
#pragma unroll
              for (int j = 0; j < 16; ++j) { const float z = zt[(w * 16 + j) * 65 + tt]; ss += z * z; }
              red[w * 64 + tt] = ss; }
            __syncthreads();
            if (F.tid < 64) { float s = 0.f;
#pragma unroll
                for (int w = 0; w < 8; ++w) s += red[w * 64 + F.tid];
                rsv[F.tid] = 1.0f / sqrtf(s * (1.0f / 128.0f) + EPS); }
            __syncthreads();
            { const int tt = F.tid >> 3, cq = F.tid & 7; const float rs = rsv[tt]; const float* nw = P.in[I_HNW] + l * HYW + gh * 128 + cq * 16; float o[16];
#pragma unroll
              for (int j = 0; j < 16; ++j) o[j] = zt[(cq * 16 + j) * 65 + tt] * rs * nw[j];
              v4u w0, w1; w0.x = pk2(o[0], o[1]); w0.y = pk2(o[2], o[3]); w0.z = pk2(o[4], o[5]); w0.w = pk2(o[6], o[7]); w1.x = pk2(o[8], o[9]); w1.y = pk2(o[10], o[11]); w1.z = pk2(o[12], o[13]); w1.w = pk2(o[14], o[15]);
              bf16* dst = Y + (size_t)(r0 + tt) * D + gh * 128 + cq * 16; *(v4u*)dst = w0; *(v4u*)(dst + 8) = w1; }
            __syncthreads();
        } else {
            const int gs = part - 8;
            for (int rr = F.wave; rr < 64; rr += NWAVES) {
                const size_t row = (size_t)(r0 + rr); const int ch = gs * 512 + F.lane * 8; const float Dh = P.in[I_SSDD][l * 16 + (ch >> 6)];
                const v4u fr = *(const v4u*)(YF + row * SSDW + ch), br = *(const v4u*)(YB + row * SSDW + ch);
                const v4u xr = *(const v4u*)(XBCC + row * XBCW + ch), zr = *(const v4u*)(ZG + row * SSDW + ch);
                float y[8]; float ss = 0.f;
#pragma unroll
                for (int e = 0; e < 4; ++e) { const float ya = (bflo(fr[e]) + bflo(br[e]) + Dh * bflo(xr[e])) * silu_f(bflo(zr[e]));
                    const float yb = (bfhi(fr[e]) + bfhi(br[e]) + Dh * bfhi(xr[e])) * silu_f(bfhi(zr[e]));
                    y[2 * e] = ya; y[2 * e + 1] = yb; ss += ya * ya + yb * yb; }
                const float rs = 1.0f / sqrtf(wave_sum(ss) * (1.0f / 512.0f) + EPS);
                const float* nw = P.in[I_SNW] + l * SSDW + ch;
                v4u w; w.x = pk2(y[0] * rs * nw[0], y[1] * rs * nw[1]); w.y = pk2(y[2] * rs * nw[2], y[3] * rs * nw[3]); w.z = pk2(y[4] * rs * nw[4], y[5] * rs * nw[5]); w.w = pk2(y[6] * rs * nw[6], y[7] * rs * nw[7]);
                *(v4u*)(Y + row * D + 1024 + ch) = w;
            }
        }
    }
}

#define RUN(g) (lo <= (g) && (g) < hi)
#define SEAM(g) do { if (RUN(g) && RUN((g) + 1)) xcd_barrier(bar); } while (0)
#ifndef HPAD
#define HPAD 0
#endif
constexpr int HP = DFF + HPAD;
template <int l> __device__ __forceinline__ void layer_phases(const Params& P, Frame& F, const XcdBarrier& bar, const int lo, const int hi) {
    unsigned char* ws = P.ws;
    const float* MOD = (const float*)(ws + WS_MOD);
    constexpr int gb = 1 + 9 * l;
#ifndef SK_NORM
    if (l == 0 && RUN(gb + 0)) filter_table_part(P, F, 0, F.bid, F.G);
    if (RUN(gb + 0)) norm_phase<0>(P, F, l, MROWS, (const float*)(ws + WS_Y), l > 0 ? 8 : 0, MOD + ((size_t)(l > 0 ? l - 1 : 0) * 5 + 4) * NMOD + 10240);
#ifdef REP_N1
    if (RUN(gb + 0) && l > 0) norm_phase<0>(P, F, l, MROWS, nullptr, 0, nullptr);
#endif
#endif
    SEAM(gb + 0);
#ifndef SK_G1
    if (RUN(gb + 1)) {
        pg8::Gemm g{(const bf16*)(ws + WS_XN), (const bf16*)(ws + WS_WIN) + (size_t)l * PROJP * D, MROWS, 5632, D, D}; pg8::StaticOrder S; S.init(MROWS, 5632, F.G, F.bid);
        pg8::EpiInProj E{(bf16*)(ws + WS_UTL), (bf16*)(ws + WS_UTC), (bf16*)(ws + WS_XBC), (bf16*)(ws + WS_ZG), (float*)(ws + WS_DT)};
        pg8::gemm_phase<pg8::EpiInProj, pg8::StaticOrder, true, true>(F.lds, g, S, E);
#ifdef REP_G1
        __syncthreads(); pg8::gemm_phase<pg8::EpiInProj, pg8::StaticOrder, true, true>(F.lds, g, S, E);
#endif
    }
#endif
    SEAM(gb + 1);
#ifndef SK_XBC
    if (RUN(gb + 2)) xbc_conv_phase(P, F, l);
#ifdef REP_XBC
    if (RUN(gb + 2)) xbc_conv_phase(P, F, l);
#endif
#endif
    SEAM(gb + 2);
#ifndef SK_MIX
    if (RUN(gb + 3)) mixer_phase_v2(P, F, l);
#ifdef REP_MIX
    if (RUN(gb + 3)) mixer_phase_v2(P, F, l);
#endif
#endif
    SEAM(gb + 3);
#ifndef SK_FIN
    if (RUN(gb + 4)) finalize_phase(P, F, l);
#ifdef REP_FIN
    if (RUN(gb + 4)) finalize_phase(P, F, l);
#endif
#endif
    SEAM(gb + 4);
#ifndef SK_G2
    if (RUN(gb + 5)) {
        pg8::Gemm g{(const bf16*)(ws + WS_Y), (const bf16*)(ws + WS_WOUT) + (size_t)l * D * D, ML, D, D, D}; pg8::StaticOrder S; S.init(ML, D, F.G, F.bid);
        pg8::EpiResid E{(bf16*)(ws + WS_XR), MOD + (size_t)l * 5 * NMOD, 4096, 1.0f};
        if (l < DEPTH - 1) {
            pg8::Gemm g2{(const bf16*)(ws + WS_Y), (const bf16*)(ws + WS_WOUT) + (size_t)l * D * D, MROWS, D, D / 4, D}; pg8::SplitKOrder S2; S2.init(ML / 256, MC / 256, D, 4, D / 4, F.G, F.bid);
            pg8::EpiPartial E2{(bf16*)(ws + WS_MIX), (D / 4) * 2, ML, MC};
            pg8::gemm_phase<pg8::EpiPartial, pg8::SplitKOrder, true, true>(F.lds, g2, S2, E2);
            __syncthreads();
        }
        pg8::gemm_phase<pg8::EpiResid, pg8::StaticOrder, true, true>(F.lds, g, S, E);
    }
#endif
    SEAM(gb + 5);
#ifndef SK_NORM
    if (RUN(gb + 6)) norm_phase<1>(P, F, l, l < DEPTH - 1 ? MROWS : ML, (const float*)(ws + WS_MIX), l < DEPTH - 1 ? 4 : 0, MOD + ((size_t)l * 5 + 4) * NMOD + 4096);
#ifdef REP_N2
    if (RUN(gb + 6)) norm_phase<1>(P, F, l, l < DEPTH - 1 ? MROWS : ML, nullptr, 0, nullptr);
#endif
#endif
    SEAM(gb + 6);
#ifndef SK_G3
    if (RUN(gb + 7)) {
        constexpr int MR = l < DEPTH - 1 ? MROWS : ML;
        pg8::Gemm g{(const bf16*)(ws + WS_XN), (const bf16*)(ws + WS_W1) + (size_t)l * DFF * D, MR, DFF, D, D}; pg8::StaticOrder S; S.init(MR, DFF, F.G, F.bid);
        pg8::EpiSqRelu E{(bf16*)(ws + WS_H), HP};
        if (l < DEPTH - 1) {
            const int nunits = (MR / 256) * (DFF / 256), nlong = nunits - (nunits / F.G) * F.G;
            if (F.bid >= nlong) { filter_table_part(P, F, l + 1, F.bid - nlong, F.G - nlong); __syncthreads(); }
        }
        pg8::gemm_phase<pg8::EpiSqRelu, pg8::StaticOrder, true, true>(F.lds, g, S, E);
#ifdef REP_G3
        __syncthreads(); pg8::gemm_phase<pg8::EpiSqRelu, pg8::StaticOrder, true, true>(F.lds, g, S, E);
#endif
    }
#endif
    SEAM(gb + 7);
#ifndef SK_G4
    if (RUN(gb + 8)) {
        pg8::Gemm g{(const bf16*)(ws + WS_H), (const bf16*)(ws + WS_W2) + (size_t)l * D * DFF, ML, D, DFF, DFF, HP}; pg8::StaticOrder S; S.init(ML, D, F.G, F.bid, 4);
        pg8::EpiResid E{(bf16*)(ws + WS_XR), MOD + (size_t)l * 5 * NMOD, 10240, 1.0f};
        const bool ctx_first = ((F.bid >> 3) & 1) != 0;
        if (l < DEPTH - 1 && ctx_first) {
            pg8::Gemm g2{(const bf16*)(ws + WS_H), (const bf16*)(ws + WS_W2) + (size_t)l * D * DFF, MROWS, D, DFF / 8, DFF, HP}; pg8::SplitKOrder S2; S2.init(ML / 256, MC / 256, D, 8, DFF / 8, F.G, F.bid);
            pg8::EpiPartial E2{(bf16*)(ws + WS_Y), (DFF / 8) * 2, ML, MC};
            pg8::gemm_phase<pg8::EpiPartial, pg8::SplitKOrder, true, true>(F.lds, g2, S2, E2);
            __syncthreads();
        }
        pg8::gemm_phase<pg8::EpiResid, pg8::StaticOrder, true, true>(F.lds, g, S, E);
        if (l < DEPTH - 1 && !ctx_first) {
            __syncthreads();
            pg8::Gemm g2{(const bf16*)(ws + WS_H), (const bf16*)(ws + WS_W2) + (size_t)l * D * DFF, MROWS, D, DFF / 8, DFF, HP}; pg8::SplitKOrder S2; S2.init(ML / 256, MC / 256, D, 8, DFF / 8, F.G, F.bid);
            pg8::EpiPartial E2{(bf16*)(ws + WS_Y), (DFF / 8) * 2, ML, MC};
            pg8::gemm_phase<pg8::EpiPartial, pg8::SplitKOrder, true, true>(F.lds, g2, S2, E2);
        }
    }
#endif
    SEAM(gb + 8);
}

__global__ void __launch_bounds__(NTHR, 2) fwd_kernel(Params P) {
    extern __shared__ __attribute__((aligned(16))) unsigned char lds_raw[];
    Frame F;
    F.lds = (LAS unsigned char*)lds_raw;
    F.tid = threadIdx.x; F.lane = F.tid & 63; F.wave = __builtin_amdgcn_readfirstlane(F.tid >> 6); F.G = gridDim.x; F.bid = blockIdx.x;
    unsigned char* ws = P.ws;
    volatile LAS unsigned* bst = (volatile LAS unsigned*)(F.lds + LDS_BYTES - 16);
    if (F.tid < 4) bst[F.tid] = 0u;
    __syncthreads();
    const int lo = P.ph_lo, hi = P.ph_hi;
    XcdBarrier bar; bar.bar = (unsigned*)(ws + WS_CTL) + CW_BAR; bar.x = 0; bar.st = bst;
    if (hi - lo > 1) bar = xcd_barrier_post((unsigned*)(ws + WS_CTL) + CW_BAR, bst);
#ifndef SK_PRO
    if (RUN(0)) prologue_phase(P, F);
#ifdef REP_PRO
    if (RUN(0)) prologue_phase(P, F);
#endif
#endif
    SEAM(0);
    layer_phases<0>(P, F, bar, lo, hi);
#ifndef ONE_LAYER
    layer_phases<1>(P, F, bar, lo, hi);
    layer_phases<2>(P, F, bar, lo, hi);
    layer_phases<3>(P, F, bar, lo, hi);
#endif
#ifndef SK_NORM
    if (RUN(37)) norm_phase<2>(P, F, 0, ML, nullptr, 0, nullptr);
#endif
}
#undef RUN
#undef SEAM

#ifndef N_LAUNCH_MODE
#define N_LAUNCH_MODE 1
#endif
extern "C" void kernel_launch(void* const* d_in, const int* in_sizes, int n_in, void* d_out, int out_size, void* d_ws, size_t ws_size, hipStream_t stream) {
    static int grid = 0;
    if (grid == 0) {
        if (n_in != N_IN || out_size != ML * D || ws_size < WS_END) { fprintf(stderr, "kernel_launch: unexpected shapes: n_in %d out %d ws %zu (need %zu)\n", n_in, out_size, ws_size, (size_t)WS_END); grid = -1; return; }
        int dev = 0, cus = 0;
        if (hipGetDevice(&dev) != hipSuccess || hipDeviceGetAttribute(&cus, hipDeviceAttributeMultiprocessorCount, dev) != hipSuccess) { grid = -1; return; }
        if (hipFuncSetAttribute((const void*)fwd_kernel, hipFuncAttributeMaxDynamicSharedMemorySize, LDS_BYTES) != hipSuccess) { fprintf(stderr, "kernel_launch: hipFuncSetAttribute failed\n"); grid = -1; return; }
        int per_cu = 0;
        if (hipOccupancyMaxActiveBlocksPerMultiprocessor(&per_cu, (const void*)fwd_kernel, NTHR, LDS_BYTES) != hipSuccess || per_cu < 1) fprintf(stderr, "kernel_launch: occupancy query reports %d\n", per_cu);
        (void)hipGetLastError();
        grid = cus;
    }
    if (grid < 0) return;
    if (hipMemsetAsync((char*)d_ws + WS_CTL, 0, CTL_ZERO_BYTES, stream) != hipSuccess) return;
    Params p{};
    for (int i = 0; i < N_IN; ++i) p.in[i] = (const float*)d_in[i];
    p.out = (float*)d_out; p.ws = (unsigned char*)d_ws;
#if N_LAUNCH_MODE == 1
    p.ph_lo = 0; p.ph_hi = NPH;
    hipLaunchKernelGGL(fwd_kernel, dim3(grid), dim3(NTHR), LDS_BYTES, stream, p);
#else
    for (int g = 0; g < NPH; ++g) { p.ph_lo = g; p.ph_hi = g + 1; hipLaunchKernelGGL(fwd_kernel, dim3(grid), dim3(NTHR), LDS_BYTES, stream, p); }
#endif
}
```

```cpp
#include <hip/hip_runtime.h>
#include <cstdio>
#include <cstdint>
namespace pg8 {
#define PG8_LAS __attribute__((address_space(3)))
typedef unsigned short bf16_t;
typedef short bf16x8 __attribute__((ext_vector_type(8)));
typedef float f32x4 __attribute__((ext_vector_type(4)));
typedef unsigned u32x4 __attribute__((ext_vector_type(4)));
constexpr int BM = 256, BK = 64, HALF = 128, HTB = HALF * BK * 2  , STAGE_BYTES = 8 * HTB, NXCD = 8, WGM = 8;

__host__ __device__ __forceinline__ int lds_byte(int r, int c) { const int st = (r >> 4) * 2 + (c >> 5), rr = r & 15, cc = c & 31, ob = rr * 64 + cc * 2; return st * 1024 + (ob ^ (((ob >> 9) & 1) << 5)); }
__host__ __device__ __forceinline__ void stage_rc(int b, int& R, int& C) { const int st = b / 1024, sb = b % 1024, swz = sb ^ (((sb >> 9) & 1) << 5); R = (st >> 1) * 16 + swz / 64; C = (st & 1) * 32 + (swz % 64) / 2; }
__host__ __device__ __forceinline__ int perm32(int rho) { const int n = rho >> 4, i = rho & 15; return 8 * (i >> 2) + 4 * n + (i & 3); }

struct Unit { int pm, pn, kb; };
struct Gemm { const bf16_t* A; const bf16_t* Bt; int M, N, K, ld, lda; };

struct StaticOrder {
    int nM, nN, nwg, G, c, wgm;
    __host__ __device__ void init(int M, int N, int G_, int c_, int wgm_ = WGM) { nM = M / BM; nN = N / BM; nwg = nM * nN; G = G_; c = c_; wgm = wgm_; }
    __host__ __device__ bool next(int i, Unit& u) const {
        const long L = (long)i * G + c; if (L >= nwg) return false;
        int wgid = (int)L; { const int q = nwg / NXCD, r = nwg % NXCD, xcd = wgid % NXCD, off = wgid / NXCD; wgid = (xcd < r ? xcd * (q + 1) : r * (q + 1) + (xcd - r) * q) + off; }
        const int nig = wgm * nN, gid = wgid / nig, fm = gid * wgm, gsz = (nM - fm) < wgm ? (nM - fm) : wgm;
        u.pm = fm + ((wgid % nig) % gsz); u.pn = (wgid % nig) / gsz; u.kb = 0; return true;
    }
    __device__ __forceinline__ void a_ready(const Unit&) const {}
    __device__ __forceinline__ void done(const Unit&) const {}
};

struct SplitKOrder {
    int pm0, nN, nS, nwg, G, c, kbytes;
    __host__ __device__ void init(int pm0_, int nMs, int N, int nS_, int K, int G_, int c_) { pm0 = pm0_; nN = N / BM; nS = nS_; nwg = nMs * nN * nS; G = G_; c = c_; kbytes = K * 2; }
    __host__ __device__ bool next(int i, Unit& u) const { const long L = (long)i * G + c; if (L >= nwg) return false; const int w = (int)L; u.kb = (w % nS) * kbytes; u.pn = (w / nS) % nN; u.pm = pm0 + w / (nS * nN); return true; }
    __device__ __forceinline__ void a_ready(const Unit&) const {}
    __device__ __forceinline__ void done(const Unit&) const {}
};

__device__ __forceinline__ unsigned cvt_pk_bf16(float lo, float hi) { unsigned r; asm volatile("v_cvt_pk_bf16_f32 %0, %1, %2" : "=v"(r) : "v"(lo), "v"(hi)); return r; }
typedef unsigned u32x2 __attribute__((ext_vector_type(2)));
struct EpiInProj {
    static constexpr bool PERM = true, AFTER_DRAIN = false;
    bf16_t* UTl; bf16_t* UTc; bf16_t* XBC; bf16_t* ZG; float* DT;
    __device__ __forceinline__ void operator()(const f32x4 (&acc)[2][2][4][2], const Unit& u, int wr, int wc, int fr, int fq) const {
        const int pn = u.pn, pm = u.pm;
        const int rloc0 = wr * 64 + fr;
        if (pn < 12) {
            bf16_t* base; int L, t0;
            if (pm < 64) { base = UTl + (size_t)(pm >> 4) * 3072 * 4096; L = 4096; t0 = (pm & 15) * 256; }
            else { base = UTc + (size_t)(pm - 64) * 3072 * 256; L = 256; t0 = 0; }
            const int odd = fr & 1;
#pragma unroll
            for (int ai = 0; ai < 2; ++ai)
#pragma unroll
                for (int m = 0; m < 4; ++m) { const int t = t0 + ai * HALF + m * 16 + rloc0;
#pragma unroll
                    for (int bj = 0; bj < 2; ++bj)
#pragma unroll
                        for (int n = 0; n < 2; ++n) { const int c = pn * BM + bj * HALF + wc * 32 + fq * 8 + n * 4; const f32x4 v = acc[ai][bj][m][n];
#pragma unroll
                            for (int pr = 0; pr < 2; ++pr) { const float va = pr ? v[2] : v[0], vb = pr ? v[3] : v[1];
                                const float send = odd ? va : vb; const float recv = __builtin_bit_cast(float, __builtin_amdgcn_mov_dpp(__builtin_bit_cast(int, send), 0xB1, 0xF, 0xF, true));
                                const float lo = odd ? recv : va, hi = odd ? vb : recv; const int ch = c + 2 * pr + odd; const int tk = t - odd;
                                *(unsigned*)(base + (size_t)ch * L + tk) = cvt_pk_bf16(lo, hi); } } }
        } else if (pn < 22) {
            bf16_t* O; int ldc, colt;
            if (pn < 18) { O = XBC; ldc = 1536; colt = (pn - 12) * BM; } else { O = ZG; ldc = 1024; colt = (pn - 18) * BM; }
            const int col0 = colt + wc * 32 + 8 * fq;
#pragma unroll
            for (int ai = 0; ai < 2; ++ai)
#pragma unroll
                for (int m = 0; m < 4; ++m) { bf16_t* rowp = O + (size_t)(pm * BM + ai * HALF + m * 16 + rloc0) * ldc + col0;
#pragma unroll
                    for (int bj = 0; bj < 2; ++bj) { const f32x4 v0 = acc[ai][bj][m][0], v1 = acc[ai][bj][m][1];
                        u32x4 w; w.x = cvt_pk_bf16(v0[0], v0[1]); w.y = cvt_pk_bf16(v0[2], v0[3]); w.z = cvt_pk_bf16(v1[0], v1[1]); w.w = cvt_pk_bf16(v1[2], v1[3]);
                        *(u32x4*)(rowp + bj * HALF) = w; } }
        } else {
            if (wc == 0) {
#pragma unroll
                for (int ai = 0; ai < 2; ++ai)
#pragma unroll
                    for (int m = 0; m < 4; ++m) { float* rowp = DT + (size_t)(pm * BM + ai * HALF + m * 16 + rloc0) * 32 + 8 * fq;
                        *(f32x4*)rowp = acc[ai][0][m][0]; *(f32x4*)(rowp + 4) = acc[ai][0][m][1]; }
            }
        }
    }
};
struct EpiResid {
    static constexpr bool PERM = true, AFTER_DRAIN = false;
    bf16_t* X; const float* mod; int goff; float s;
    __device__ __forceinline__ void operator()(const f32x4 (&acc)[2][2][4][2], const Unit& u, int wr, int wc, int fr, int fq) const {
        const int brow = u.pm < 64 ? (u.pm >> 4) : 4;
        const int row0 = u.pm * BM + wr * 64 + fr, col0 = u.pn * BM + wc * 32 + 8 * fq;
        const float* g = mod + brow * 12288 + goff + col0;
        f32x4 gv[2][2];
#pragma unroll
        for (int bj = 0; bj < 2; ++bj)
#pragma unroll
            for (int n = 0; n < 2; ++n) gv[bj][n] = *(const f32x4*)(g + bj * HALF + 4 * n) * s;
#pragma unroll
        for (int ai = 0; ai < 2; ++ai)
#pragma unroll
            for (int m = 0; m < 4; ++m) { bf16_t* rowp = X + (size_t)(row0 + ai * HALF + m * 16) * 2048 + col0;
#pragma unroll
                for (int bj = 0; bj < 2; ++bj) { const u32x4 o = *(const u32x4*)(rowp + bj * HALF);
                    f32x4 x0 = {__builtin_bit_cast(float, o.x << 16), __builtin_bit_cast(float, o.x & 0xffff0000u), __builtin_bit_cast(float, o.y << 16), __builtin_bit_cast(float, o.y & 0xffff0000u)};
                    f32x4 x1 = {__builtin_bit_cast(float, o.z << 16), __builtin_bit_cast(float, o.z & 0xffff0000u), __builtin_bit_cast(float, o.w << 16), __builtin_bit_cast(float, o.w & 0xffff0000u)};
                    x0 += gv[bj][0] * acc[ai][bj][m][0]; x1 += gv[bj][1] * acc[ai][bj][m][1];
                    u32x4 w; w.x = cvt_pk_bf16(x0[0], x0[1]); w.y = cvt_pk_bf16(x0[2], x0[3]); w.z = cvt_pk_bf16(x1[0], x1[1]); w.w = cvt_pk_bf16(x1[2], x1[3]);
                    *(u32x4*)(rowp + bj * HALF) = w; }
                asm volatile("" ::: "memory"); }
    }
};
struct EpiPartial {
    static constexpr bool PERM = true, AFTER_DRAIN = false;
    bf16_t* part; int kbytes, row0, nrows;
    __device__ __forceinline__ void operator()(const f32x4 (&acc)[2][2][4][2], const Unit& u, int wr, int wc, int fr, int fq) const {
        const int ks = u.kb / kbytes;
        const int rloc = u.pm * BM - row0 + wr * 64 + fr, col0 = u.pn * BM + wc * 32 + 8 * fq;
        bf16_t* base = part + ((size_t)ks * nrows + rloc) * 2048 + col0;
#pragma unroll
        for (int ai = 0; ai < 2; ++ai)
#pragma unroll
            for (int m = 0; m < 4; ++m) { bf16_t* rowp = base + (size_t)(ai * HALF + m * 16) * 2048;
#pragma unroll
                for (int bj = 0; bj < 2; ++bj) { const f32x4 v0 = acc[ai][bj][m][0], v1 = acc[ai][bj][m][1];
                    u32x4 w; w.x = cvt_pk_bf16(v0[0], v0[1]); w.y = cvt_pk_bf16(v0[2], v0[3]); w.z = cvt_pk_bf16(v1[0], v1[1]); w.w = cvt_pk_bf16(v1[2], v1[3]);
                    *(u32x4*)(rowp + bj * HALF) = w; } }
    }
};
struct EpiSqRelu {
    static constexpr bool PERM = true, AFTER_DRAIN = false;
    bf16_t* O; int ldc;
    __device__ __forceinline__ void operator()(const f32x4 (&acc)[2][2][4][2], const Unit& u, int wr, int wc, int fr, int fq) const {
        const int row0 = u.pm * BM + wr * 64 + fr, col0 = u.pn * BM + wc * 32 + 8 * fq;
#pragma unroll
        for (int ai = 0; ai < 2; ++ai)
#pragma unroll
            for (int m = 0; m < 4; ++m) { bf16_t* rowp = O + (size_t)(row0 + ai * HALF + m * 16) * ldc + col0;
#pragma unroll
                for (int bj = 0; bj < 2; ++bj) { f32x4 v0 = acc[ai][bj][m][0], v1 = acc[ai][bj][m][1];
#pragma unroll
                    for (int j = 0; j < 4; ++j) { const float a = v0[j] > 0.f ? v0[j] : 0.f, b = v1[j] > 0.f ? v1[j] : 0.f; v0[j] = a * a; v1[j] = b * b; }
                    u32x4 w; w.x = cvt_pk_bf16(v0[0], v0[1]); w.y = cvt_pk_bf16(v0[2], v0[3]); w.z = cvt_pk_bf16(v1[0], v1[1]); w.w = cvt_pk_bf16(v1[2], v1[3]);
                    *(u32x4*)(rowp + bj * HALF) = w; } }
    }
};
template <class Epi, class Sched, bool ALIGN_EPI = false, bool SP2 = false>
__device__ __forceinline__ void gemm_phase(PG8_LAS unsigned char* lds, const Gemm g, const Sched& S, const Epi& E) {
    const int tid = threadIdx.x, wid = __builtin_amdgcn_readfirstlane(tid >> 6), lane = tid & 63, wr = wid >> 2, wc = wid & 3, fr = lane & 15, fq = lane >> 4;
    const int K = g.K, nt = K / BK;
    const int lda = g.lda ? g.lda : g.ld;
    unsigned voffA[2], voffB[2];
#pragma unroll
    for (int i = 0; i < 2; ++i) { int R, C; stage_rc(tid * 16 + i * 8192, R, C); const int Rb = Epi::PERM ? ((R & ~31) + perm32(R & 31)) : R;
        voffA[i] = (unsigned)(R * lda + C) * 2u; voffB[i] = (unsigned)(Rb * g.ld + C) * 2u; }
    const size_t kstep = (size_t)(BK * 2);
    const size_t hstep = (size_t)HALF * g.ld * 2;
    const size_t tstep = 2 * hstep;
    const size_t hstepA = (size_t)HALF * lda * 2, tstepA = 2 * hstepA;
    const unsigned ldsw = (unsigned)wid * 1024u;
    const int aoff = lds_byte(wr * 64 + fr, fq * 8), boff = lds_byte(wc * 32 + fr, fq * 8);
#define PG8_SA(b, h) (((b) * 2 + (h)) * HTB)
#define PG8_SB(b, h) ((4 + (b) * 2 + (h)) * HTB)
#define PG8_STAGE(bufoff, gbase, voff) do { _Pragma("unroll") for (int _i = 0; _i < 2; ++_i) \
        __builtin_amdgcn_global_load_lds((const unsigned*)((const char*)(gbase) + (voff)[_i]), (PG8_LAS unsigned*)(lds + (bufoff) + ldsw + _i * 8192), 16, 0, 0); } while (0)
#define PG8_LDA(dst, b, h) do { _Pragma("unroll") for (int m = 0; m < 4; ++m) _Pragma("unroll") for (int k = 0; k < 2; ++k) dst[m][k] = *(const PG8_LAS bf16x8*)(lds + PG8_SA(b, h) + aoff + m * 2048 + k * 1024); } while (0)
#define PG8_LDB(dst, b, h) do { _Pragma("unroll") for (int n = 0; n < 2; ++n) _Pragma("unroll") for (int k = 0; k < 2; ++k) dst[n][k] = *(const PG8_LAS bf16x8*)(lds + PG8_SB(b, h) + boff + n * 2048 + k * 1024); } while (0)
#define PG8_MMA(ai, bj, At, Bt) do { __builtin_amdgcn_s_setprio(1); _Pragma("unroll") for (int m = 0; m < 4; ++m) _Pragma("unroll") for (int n = 0; n < 2; ++n) _Pragma("unroll") for (int k = 0; k < 2; ++k) \
        acc[ai][bj][m][n] = __builtin_amdgcn_mfma_f32_16x16x32_bf16(Bt[n][k], At[m][k], acc[ai][bj][m][n], 0, 0, 0); __builtin_amdgcn_s_setprio(0); } while (0)
#define PG8_WAIT_V(n) asm volatile("s_waitcnt vmcnt(" #n ")" ::: "memory")
#define PG8_WAIT_L(n) asm volatile("s_waitcnt lgkmcnt(" #n ")" ::: "memory")
#define PG8_BAR __builtin_amdgcn_s_barrier()
#define PG8_SCHED __builtin_amdgcn_sched_barrier(0)
    Unit cur, nxt; int ui = 0;
    if (!S.next(0, cur)) return;
    f32x4 acc[2][2][4][2];
#pragma unroll
    for (int a = 0; a < 2; ++a)
#pragma unroll
        for (int b = 0; b < 2; ++b)
#pragma unroll
            for (int m = 0; m < 4; ++m)
#pragma unroll
                for (int n = 0; n < 2; ++n) acc[a][b][m][n] = (f32x4){0.f, 0.f, 0.f, 0.f};
    bf16x8 At[4][2], B0[2][2], B1[2][2];
    const char* cA = (const char*)g.A + (size_t)cur.pm * tstepA + cur.kb; const char* cB = (const char*)g.Bt + (size_t)cur.pn * tstep + cur.kb;
    S.a_ready(cur);
    if constexpr (SP2) {
        PG8_STAGE(PG8_SB(0, 0), cB, voffB); PG8_STAGE(PG8_SB(0, 1), cB + hstep, voffB); PG8_STAGE(PG8_SA(0, 0), cA, voffA); PG8_STAGE(PG8_SA(0, 1), cA + hstepA, voffA);
        if (wr == 1) PG8_BAR;
        PG8_WAIT_V(2); PG8_BAR;
        PG8_STAGE(PG8_SB(1, 0), cB + kstep, voffB); PG8_STAGE(PG8_SA(1, 0), cA + kstep, voffA); PG8_STAGE(PG8_SB(1, 1), cB + hstep + kstep, voffB);
        PG8_WAIT_V(6); PG8_BAR;
    } else {
        PG8_STAGE(PG8_SB(0, 0), cB, voffB); PG8_STAGE(PG8_SA(0, 0), cA, voffA); PG8_STAGE(PG8_SB(0, 1), cB + hstep, voffB); PG8_STAGE(PG8_SA(0, 1), cA + hstepA, voffA);
        if (wr == 1) PG8_BAR;
        PG8_WAIT_V(4); PG8_BAR;
        PG8_STAGE(PG8_SB(1, 0), cB + kstep, voffB); PG8_STAGE(PG8_SA(1, 0), cA + kstep, voffA); PG8_STAGE(PG8_SB(1, 1), cB + hstep + kstep, voffB);
        PG8_WAIT_V(6); PG8_BAR;
    }
    for (;;) {
        const bool has_next = S.next(ui + 1, nxt);
        const char* nA = has_next ? (const char*)g.A + (size_t)nxt.pm * tstepA + nxt.kb : cA; const char* nB = has_next ? (const char*)g.Bt + (size_t)nxt.pn * tstep + nxt.kb : cB;
        for (int t = 0; t < nt; t += 2) {
            const bool last = (t == nt - 2);
            const char* a1 = cA + (size_t)(t + 1) * kstep;
            const char* a2 = last ? nA : cA + (size_t)(t + 2) * kstep; const char* b2 = last ? nB : cB + (size_t)(t + 2) * kstep;
            const char* a3 = a2 + kstep; const char* b3 = b2 + kstep;
            if (last && has_next) S.a_ready(nxt);
            if constexpr (SP2) {
            PG8_LDB(B0, 0, 0); PG8_LDB(B1, 0, 1); PG8_SCHED; PG8_LDA(At, 0, 0); PG8_STAGE(PG8_SA(1, 1), a1 + hstepA, voffA);
            PG8_WAIT_V(8); PG8_WAIT_L(0); PG8_BAR; PG8_MMA(0, 0, At, B0); PG8_MMA(0, 1, At, B1); PG8_BAR; PG8_SCHED;
            PG8_LDA(At, 0, 1); PG8_STAGE(PG8_SB(0, 0), b2, voffB); PG8_STAGE(PG8_SB(0, 1), b2 + hstep, voffB); PG8_STAGE(PG8_SA(0, 0), a2, voffA);
            PG8_WAIT_V(8); PG8_WAIT_L(0); PG8_BAR; PG8_MMA(1, 0, At, B0); PG8_MMA(1, 1, At, B1); PG8_BAR; PG8_SCHED;
            PG8_LDB(B0, 1, 0); PG8_LDB(B1, 1, 1); PG8_SCHED; PG8_LDA(At, 1, 0); PG8_STAGE(PG8_SA(0, 1), a2 + hstepA, voffA);
            PG8_WAIT_V(8); PG8_WAIT_L(0); PG8_BAR; PG8_MMA(0, 0, At, B0); PG8_MMA(0, 1, At, B1); PG8_BAR; PG8_SCHED;
            PG8_LDA(At, 1, 1); PG8_STAGE(PG8_SB(1, 0), b3, voffB); PG8_STAGE(PG8_SB(1, 1), b3 + hstep, voffB); PG8_STAGE(PG8_SA(1, 0), a3, voffA);
            PG8_WAIT_V(8); PG8_WAIT_L(0); PG8_BAR; PG8_MMA(1, 0, At, B0); PG8_MMA(1, 1, At, B1); PG8_BAR; PG8_SCHED;
            } else {
            PG8_LDB(B0, 0, 0); PG8_SCHED; PG8_LDA(At, 0, 0); PG8_STAGE(PG8_SA(1, 1), a1 + hstepA, voffA);
            PG8_WAIT_L(8); PG8_BAR; PG8_WAIT_L(0); PG8_MMA(0, 0, At, B0); PG8_BAR; PG8_SCHED;
            PG8_LDB(B1, 0, 1); PG8_STAGE(PG8_SB(0, 0), b2, voffB);
            PG8_BAR; PG8_WAIT_L(0); PG8_MMA(0, 1, At, B1); PG8_BAR;
            PG8_LDA(At, 0, 1); PG8_STAGE(PG8_SA(0, 0), a2, voffA);
            PG8_BAR; PG8_WAIT_L(0); PG8_MMA(1, 0, At, B0); PG8_BAR; PG8_SCHED;
            PG8_STAGE(PG8_SB(0, 1), b2 + hstep, voffB);
            PG8_WAIT_V(6); PG8_BAR; PG8_MMA(1, 1, At, B1); PG8_BAR;
            PG8_LDB(B0, 1, 0); PG8_SCHED; PG8_LDA(At, 1, 0); PG8_STAGE(PG8_SA(0, 1), a2 + hstepA, voffA);
            PG8_WAIT_L(8); PG8_BAR; PG8_WAIT_L(0); PG8_MMA(0, 0, At, B0); PG8_BAR; PG8_SCHED;
            PG8_LDB(B1, 1, 1); PG8_STAGE(PG8_SB(1, 0), b3, voffB);
            PG8_BAR; PG8_WAIT_L(0); PG8_MMA(0, 1, At, B1); PG8_BAR;
            PG8_LDA(At, 1, 1); PG8_STAGE(PG8_SA(1, 0), a3, voffA);
            PG8_BAR; PG8_WAIT_L(0); PG8_MMA(1, 0, At, B0); PG8_BAR; PG8_SCHED;
            PG8_STAGE(PG8_SB(1, 1), b3 + hstep, voffB);
            PG8_WAIT_V(6); PG8_BAR; PG8_MMA(1, 1, At, B1); PG8_BAR;
            }
        }
        if constexpr (ALIGN_EPI) { if (wr == 0) PG8_BAR; }
        if constexpr (!Epi::AFTER_DRAIN) { E(acc, cur, wr, wc, fr, fq); S.done(cur); }
        if (!has_next) break;
#pragma unroll
        for (int a = 0; a < 2; ++a)
#pragma unroll
            for (int b = 0; b < 2; ++b)
#pragma unroll
                for (int m = 0; m < 4; ++m)
#pragma unroll
                    for (int n = 0; n < 2; ++n) acc[a][b][m][n] = (f32x4){0.f, 0.f, 0.f, 0.f};
        cur = nxt; cA = nA; cB = nB; ++ui;
        if constexpr (ALIGN_EPI) { if (wr == 1) PG8_BAR; }
    }
    PG8_WAIT_V(0);
    if constexpr (!ALIGN_EPI) { if (wr == 0) PG8_BAR; }
    PG8_BAR;
    if constexpr (Epi::AFTER_DRAIN) { E.fused(acc, cur, wr, wc, fr, fq, lds, wid, lane); S.done(cur); }
#undef PG8_SA
#undef PG8_SB
#undef PG8_STAGE
#undef PG8_LDA
#undef PG8_LDB
#undef PG8_MMA
#undef PG8_WAIT_V
#undef PG8_WAIT_L
#undef PG8_BAR
#undef PG8_SCHED
}
}
#define XB_TMO      128
#define XB_XCNT(j)  (256  + 64 * (j))
#define XB_XSUB(j)  (1280 + 64 * (j))
#define XB_XGEN(j)  (2304 + 64 * (j))
#define XB_TOP      3328
#define XB_TOPGEN   3392
#define XCD_BAR_WORDS 3456
#define XB_SPIN_CAP (1u << 18)
#define LAS __attribute__((address_space(3)))

__device__ __forceinline__ unsigned xb_ld(unsigned* p)              { return __hip_atomic_load(p, __ATOMIC_RELAXED, __HIP_MEMORY_SCOPE_AGENT); }
__device__ __forceinline__ unsigned xb_add(unsigned* p, unsigned v) { return __hip_atomic_fetch_add(p, v, __ATOMIC_RELAXED, __HIP_MEMORY_SCOPE_AGENT); }
__device__ __forceinline__ unsigned xb_xcc_id() { return (unsigned)__builtin_amdgcn_s_getreg((3 << 11) | 20) & 0xFu; }
#define XB_SPIN(cond, bar) do { unsigned _sp = 0; while (cond) { __builtin_amdgcn_s_sleep(1); \
    if ((++_sp & 255u) == 0u) { if (xb_ld(&(bar)[XB_TMO])) break; if (_sp > XB_SPIN_CAP) { atomicAdd(&(bar)[XB_TMO], 1u); break; } } } } while (0)

struct XcdBarrier {
    unsigned* bar; unsigned x;
    volatile LAS unsigned* st;
};

__device__ __forceinline__ XcdBarrier xcd_barrier_post(unsigned* bar, volatile LAS unsigned* st) {
    XcdBarrier b; b.bar = bar; b.x = xb_xcc_id(); b.st = st;
    if (threadIdx.x == 0) (void)xb_add(&bar[XB_XCNT(b.x)], 1u);
    return b;
}
__device__ __forceinline__ void xcd_barrier_complete(unsigned* bar, unsigned x, unsigned& nloc, unsigned& nx) {
    const unsigned G = gridDim.x * gridDim.y * gridDim.z;
    unsigned sum, cnt, mine, sp = 0u;
    for (;;) {
        sum = 0u; cnt = 0u; mine = 0u;
#pragma unroll
        for (unsigned j = 0; j < 16; ++j) { const unsigned c = xb_ld(&bar[XB_XCNT(j)]); sum += c; cnt += (c > 0u) ? 1u : 0u; mine = (j == x) ? c : mine; }
        if (sum == G) break;
        __builtin_amdgcn_s_sleep(1);
        if ((++sp & 255u) == 0u) { if (xb_ld(&bar[XB_TMO])) break; if (sp > XB_SPIN_CAP) { atomicAdd(&bar[XB_TMO], 1u); break; } }
    }
    nloc = mine > 0u ? mine : 1u; nx = cnt > 0u ? cnt : 1u;
}

__device__ __forceinline__ void xcd_barrier(const XcdBarrier& b) {
    asm volatile("s_waitcnt vmcnt(0)" ::: "memory");
    __syncthreads();
    if (threadIdx.x == 0) {
        unsigned* bar = b.bar;
        __builtin_amdgcn_s_waitcnt(0);
        unsigned nloc = b.st[0], nx = b.st[1];
        if (nloc == 0u) { xcd_barrier_complete(bar, b.x, nloc, nx); b.st[0] = nloc; b.st[1] = nx; }
        const unsigned old = xb_add(&bar[XB_XSUB(b.x)], 1u);
        const unsigned gen = old / nloc;
        if (old + 1u == (gen + 1u) * nloc) {
            __builtin_amdgcn_fence(__ATOMIC_RELEASE, "agent");
            asm volatile("s_waitcnt vmcnt(0)" ::: "memory");
            const unsigned og = xb_add(&bar[XB_TOP], 1u);
            const unsigned tg = og / nx;
            if (og + 1u == (tg + 1u) * nx) xb_add(&bar[XB_TOPGEN], 1u);
            else XB_SPIN(xb_ld(&bar[XB_TOPGEN]) == tg, bar);
            __builtin_amdgcn_fence(__ATOMIC_ACQUIRE, "agent");
            xb_add(&bar[XB_XGEN(b.x)], 1u);
            asm volatile("s_waitcnt vmcnt(0)" ::: "memory");
        } else {
            XB_SPIN(xb_ld(&bar[XB_XGEN(b.x)]) == gen, bar);
            __builtin_amdgcn_fence(__ATOMIC_ACQUIRE, "agent");
            asm volatile("s_waitcnt vmcnt(0)" ::: "memory");
        }
    }
    __syncthreads();
}
#define GAS __attribute__((address_space(1)))
typedef unsigned short bf16;
typedef unsigned v4u __attribute__((ext_vector_type(4)));
typedef unsigned v2u __attribute__((ext_vector_type(2)));
typedef float f32x4 __attribute__((ext_vector_type(4)));
constexpr int NWAVES = 8, NTHR = 512;
constexpr int D = 2048, NB = 4, SEQ = 4096, CTX = 256, DEPTH = 4;
constexpr int ML = NB * SEQ, MC = NB * CTX, MROWS = ML + MC;
constexpr int HYW = 1024, HYP = 3072, XBCW = 1536, SSDW = 1024, PROJ = 5664, PROJP = 5888, DFF = 8192, NMOD = 12288;
constexpr float EPS = 1e-6f;
constexpr int LDS_BYTES = 155648;

enum { I_X = 0, I_C, I_CTX, I_CCTX, I_WADA, I_BADA, I_N1W, I_WIN, I_HCW, I_HCB, I_FW1, I_FB1, I_FFREQ, I_FW2, I_FB2, I_FW3, I_HBIAS, I_HNW, I_SCW, I_SCB, I_DTB, I_ALOG, I_SSDD, I_SNW, I_WOUT, I_N2W, I_W1, I_W2, I_FNW, N_IN };

constexpr size_t MiB = (size_t)1 << 20;
constexpr size_t WS_CTL = 0, CTL_ZERO_BYTES = 64 * 1024;
constexpr size_t WS_MOD = 1 * MiB;
constexpr size_t WS_HDNL = 2 * MiB;
constexpr size_t WS_HDNC = 6 * MiB;
constexpr size_t WS_DT = 8 * MiB;
constexpr size_t WS_WIN = 16 * MiB;
constexpr size_t WS_WOUT = 108 * MiB;
constexpr size_t WS_W1 = 140 * MiB;
constexpr size_t WS_W2 = 268 * MiB;
constexpr size_t WS_XR = 396 * MiB;
constexpr size_t WS_XN = 532 * MiB;
constexpr size_t WS_Y = 600 * MiB;
constexpr size_t WS_MIX = 668 * MiB;
constexpr size_t WS_UTL = WS_MIX;
constexpr size_t WS_UTC = WS_MIX + 96 * MiB;
constexpr size_t WS_XBC = WS_MIX + 102 * MiB;
constexpr size_t WS_XBCC = WS_MIX + 153 * MiB;
constexpr size_t WS_ZG = WS_MIX + 204 * MiB;
constexpr size_t WS_YF = WS_MIX + 238 * MiB;
constexpr size_t WS_YB = WS_MIX + 306 * MiB;
constexpr size_t WS_ZTL = WS_MIX + 374 * MiB;
constexpr size_t WS_ZTC = WS_MIX + 406 * MiB;
constexpr size_t WS_H = WS_MIX;
constexpr size_t WS_FSCR = WS_MIX + 408 * MiB;
constexpr size_t WS_ZIN = WS_MIX + 440 * MiB;
constexpr size_t WS_FSG = WS_MIX + 456 * MiB;
constexpr size_t WS_INV = WS_MIX + 520 * MiB;
constexpr size_t WS_FW3T = WS_MIX + 521 * MiB;
constexpr size_t WS_END = WS_MIX + 525 * MiB;
constexpr int CW_BAR = 4096;

constexpr int NPH = 38;

struct Params { const float* in[N_IN]; float* out; unsigned char* ws; int ph_lo, ph_hi; };

#define LDS_WAIT() asm volatile("s_waitcnt lgkmcnt(0)" ::: "memory")
#define LDS_BARRIER() do { asm volatile("s_waitcnt lgkmcnt(0)" ::: "memory"); __builtin_amdgcn_s_barrier(); asm volatile("" ::: "memory"); } while (0)
__device__ __forceinline__ float wave_sum(float v) {
#pragma unroll
    for (int o = 1; o < 64; o <<= 1) v += __shfl_xor(v, o);
    return v;
}
__device__ __forceinline__ unsigned f2bf(float f) { unsigned u = __builtin_bit_cast(unsigned, f); return (u + 0x7fffu + ((u >> 16) & 1u)) >> 16; }
typedef float pk2_f2 __attribute__((ext_vector_type(2))); typedef __bf16 pk2_b2 __attribute__((ext_vector_type(2)));
__device__ __forceinline__ unsigned pk2(float lo, float hi) { const pk2_f2 v = {lo, hi}; return __builtin_bit_cast(unsigned, __builtin_convertvector(v, pk2_b2)); }
__device__ __forceinline__ float bflo(unsigned w) { return __builtin_bit_cast(float, w << 16); }
__device__ __forceinline__ float bfhi(unsigned w) { return __builtin_bit_cast(float, w & 0xffff0000u); }
__device__ __forceinline__ float bf2f(bf16 h) { return __builtin_bit_cast(float, (unsigned)h << 16); }
__device__ __forceinline__ float silu_f(float x) { return x * __builtin_amdgcn_rcpf(1.f + __expf(-x)); }
__device__ __forceinline__ float softplus_f(float x) { const float y = __expf(x); return x > 20.f ? x : (x < -5.f ? y * (1.f - 0.5f * y) : __logf(1.f + y)); }

struct Frame { LAS unsigned char* lds; int tid, lane, wave, G, bid; };

__device__ __forceinline__ void transpose_item(const float* W, int K, int N, bf16* WT, int k0, int n0, int drow0, LAS float* scr, int lane) {
#pragma unroll 8
    for (int i = 0; i < 32; ++i) { const int kk = 2 * i + (lane >> 5); scr[kk * 33 + (lane & 31)] = W[(size_t)(k0 + kk) * N + n0 + (lane & 31)]; }
    LDS_WAIT(); asm volatile("" ::: "memory");
    const int c = lane & 7;
#pragma unroll
    for (int j = 0; j < 4; ++j) { const int n = (lane >> 3) + 8 * j; const LAS float* s = scr + (8 * c) * 33 + n;
        v4u o; o.x = pk2(s[0 * 33], s[1 * 33]); o.y = pk2(s[2 * 33], s[3 * 33]); o.z = pk2(s[4 * 33], s[5 * 33]); o.w = pk2(s[6 * 33], s[7 * 33]);
        *(v4u*)(WT + (size_t)(drow0 + n) * K + k0 + 8 * c) = o; }
    LDS_WAIT(); asm volatile("" ::: "memory");
}

__device__ __forceinline__ void prologue_phase(const Params& P, Frame& F) {
    unsigned char* ws = P.ws;
    {
        LAS float* sc = (LAS float*)F.lds;
        LAS float* red = (LAS float*)(F.lds + 40960);
        for (int i = F.tid; i < 5 * 2048; i += NTHR) { const int r = i >> 11, k = i & 2047; const float v = r < 4 ? P.in[I_C][r * 2048 + k] : P.in[I_CCTX][k]; sc[i] = silu_f(v); }
        __syncthreads();
        float* MOD = (float*)(ws + WS_MOD);
        const int kq = F.tid >> 4, cq = F.tid & 15;
        for (int it = F.bid; it < 4 * 192; it += F.G) {
            const int l = it / 192, cb = it % 192;
            const float* wp = P.in[I_WADA] + (size_t)l * 2048 * NMOD + 64 * cb + 4 * cq;
            f32x4 a0 = {0.f, 0.f, 0.f, 0.f}, a1 = a0, a2 = a0, a3 = a0, a4 = a0;
#pragma unroll 4
            for (int k = kq; k < 2048; k += 32) { const f32x4 w = *(const f32x4*)(wp + (size_t)k * NMOD);
                a0 += w * sc[k]; a1 += w * sc[2048 + k]; a2 += w * sc[4096 + k]; a3 += w * sc[6144 + k]; a4 += w * sc[8192 + k]; }
            LAS f32x4* rp = (LAS f32x4*)red + (kq * 5) * 16 + cq;
            rp[0] = a0; rp[16] = a1; rp[32] = a2; rp[48] = a3; rp[64] = a4;
            __syncthreads();
            if (F.tid < 320) { const int r = F.tid >> 6, col = F.tid & 63; float s = 0.f;
#pragma unroll 8
                for (int q = 0; q < 32; ++q) s += red[(q * 5 + r) * 64 + col];
                MOD[(size_t)(l * 5 + r) * NMOD + 64 * cb + col] = s + P.in[I_BADA][(size_t)l * NMOD + 64 * cb + col]; }
            __syncthreads();
        }
    }
    __syncthreads();
    const int gw = F.bid * NWAVES + F.wave, NGW = F.G * NWAVES;
    {
        LAS float* scr = (LAS float*)(F.lds + F.wave * 16384);
        bf16* Win_t = (bf16*)(ws + WS_WIN); bf16* Wout_t = (bf16*)(ws + WS_WOUT); bf16* W1_t = (bf16*)(ws + WS_W1); bf16* W2_t = (bf16*)(ws + WS_W2);
        constexpr int I_IN = 32 * 177, I_OUT = 32 * 64, I_M1 = 32 * 256, I_M2 = 128 * 64, I_LAYER = I_IN + I_OUT + I_M1 + I_M2;
        for (int it = gw; it < DEPTH * I_LAYER; it += NGW) {
            const int l = it / I_LAYER; int r = it % I_LAYER;
            if (r < I_IN) { const int kb = r / 177, nb = r % 177, n0 = 32 * nb; const int dst = n0 < 4608 ? n0 : (n0 < 4640 ? 5632 + (n0 - 4608) : n0 - 32);
                transpose_item(P.in[I_WIN] + (size_t)l * D * PROJ, D, PROJ, Win_t + (size_t)l * PROJP * D, 64 * kb, n0, dst, scr, F.lane); continue; }
            r -= I_IN;
            if (r < I_OUT) { const int kb = r / 64, nb = r % 64; transpose_item(P.in[I_WOUT] + (size_t)l * D * D, D, D, Wout_t + (size_t)l * D * D, 64 * kb, 32 * nb, 32 * nb, scr, F.lane); continue; }
            r -= I_OUT;
            if (r < I_M1) { const int kb = r / 256, nb = r % 256; transpose_item(P.in[I_W1] + (size_t)l * D * DFF, D, DFF, W1_t + (size_t)l * DFF * D, 64 * kb, 32 * nb, 32 * nb, scr, F.lane); continue; }
            r -= I_M1;
            { const int kb = r / 64, nb = r % 64; transpose_item(P.in[I_W2] + (size_t)l * DFF * D, DFF, D, W2_t + (size_t)l * D * DFF, 64 * kb, 32 * nb, 32 * nb, scr, F.lane); }
        }
        const v4u z = {0u, 0u, 0u, 0u};
        for (int i = F.bid * NTHR + F.tid; i < DEPTH * 57344; i += F.G * NTHR) { const int l = i / 57344, o = i % 57344; ((v4u*)(Win_t + ((size_t)l * PROJP + PROJ) * D))[o] = z; }
    }
    {
        bf16* HLh = (bf16*)(ws + WS_HDNL); float* HC = (float*)(ws + WS_HDNC);
        { bf16* FT = (bf16*)(ws + WS_FW3T);
          for (int i = F.bid * NTHR + F.tid; i < DEPTH * 4096 * 64; i += F.G * NTHR) { const int l = i >> 18, col = (i >> 6) & 4095, jj = i & 63; const float v = P.in[I_FW3][((size_t)l * 64 + jj) * 4096 + col];
              const unsigned hi = f2bf(v); FT[i] = (bf16)hi; FT[(size_t)DEPTH * 4096 * 64 + i] = (bf16)f2bf(v - __builtin_bit_cast(float, hi << 16)); } }
        const int j = F.lane;
        for (int w = gw; w < DEPTH * 4352; w += NGW) {
            const int l = w / 4352, tt = w % 4352; const bool lat = tt < 4096; const int t = lat ? tt : tt - 4096, L = lat ? 4096 : 256;
            const float tl = (float)t / (float)(L - 1);
            const float wv = (6.283185307179586f * (float)t) / (float)L;
            const float fi = 1e-4f + (float)(j & 15) * ((15.0f - 1e-4f) / 15.0f);
            const float ang = fi * wv;
            const float feat = (j < 16) ? cosf(ang) : -sinf(ang);
            const float* fw1 = P.in[I_FW1] + (size_t)l * 33 * 64; const float* fw2 = P.in[I_FW2] + (size_t)l * 64 * 64;
            const float fr = P.in[I_FFREQ][l * 64 + j];
            float pre = P.in[I_FB1][l * 64 + j] + tl * fw1[j];
#pragma unroll 8
            for (int i = 0; i < 32; ++i) pre += __shfl(feat, i) * fw1[(1 + i) * 64 + j];
            const float h1 = sinf(fr * pre);
            float pre2 = P.in[I_FB2][l * 64 + j];
#pragma unroll 8
            for (int i = 0; i < 64; ++i) pre2 += __shfl(h1, i) * fw2[i * 64 + j];
            const float h2 = sinf(fr * pre2);
            if (lat) { const unsigned hi = f2bf(h2); const float rem = h2 - __builtin_bit_cast(float, hi << 16);
                HLh[((size_t)l * 4096 + t) * 64 + j] = (bf16)hi; HLh[(size_t)DEPTH * 4096 * 64 + ((size_t)l * 4096 + t) * 64 + j] = (bf16)f2bf(rem); }
            else HC[((size_t)l * 64 + j) * 256 + t] = h2;
        }
    }
}

template <int KIND> __device__ __forceinline__ void norm_phase(const Params& P, Frame& F, int l, int nrows, const float* part, int nsplit, const float* pgate) {
    unsigned char* ws = P.ws;
    bf16* XR = (bf16*)(ws + WS_XR); bf16* XN = (bf16*)(ws + WS_XN); const float* MOD = (const float*)(ws + WS_MOD);
    const int gw = F.bid * NWAVES + F.wave, NGW = F.G * NWAVES;
    const float* nw = (KIND == 0) ? P.in[I_N1W] + l * D : (KIND == 1 ? P.in[I_N2W] + l * D : P.in[I_FNW]);
    for (int row = gw; row < nrows; row += NGW) {
        float v[4][8]; float ss = 0.f; bool wr_xr = false;
        if (KIND == 0 && l == 0) {
            const float* src = row < ML ? P.in[I_X] + (size_t)row * D : P.in[I_CTX] + (size_t)(row - ML) * D; wr_xr = true;
#pragma unroll
            for (int j = 0; j < 4; ++j) { const f32x4 a = ((const f32x4*)src)[2 * (F.lane + 64 * j)], b = ((const f32x4*)src)[2 * (F.lane + 64 * j) + 1];
                v[j][0] = a.x; v[j][1] = a.y; v[j][2] = a.z; v[j][3] = a.w; v[j][4] = b.x; v[j][5] = b.y; v[j][6] = b.z; v[j][7] = b.w; }
        } else {
#pragma unroll
            for (int j = 0; j < 4; ++j) { const v4u w = ((const v4u*)(XR + (size_t)row * D))[F.lane + 64 * j];
#pragma unroll
                for (int e = 0; e < 4; ++e) { v[j][2 * e] = bflo(w[e]); v[j][2 * e + 1] = bfhi(w[e]); } }
        }
        if (nsplit > 0 && row >= ML) {
            wr_xr = true;
#pragma unroll
            for (int j = 0; j < 4; ++j) { f32x4 a0 = {0.f, 0.f, 0.f, 0.f}, a1 = a0;
                for (int sp = 0; sp < nsplit; ++sp) { const v4u pw = ((const v4u*)((const bf16*)part + ((size_t)sp * MC + (row - ML)) * D))[F.lane + 64 * j];
                    a0 += (f32x4){bflo(pw.x), bfhi(pw.x), bflo(pw.y), bfhi(pw.y)}; a1 += (f32x4){bflo(pw.z), bfhi(pw.z), bflo(pw.w), bfhi(pw.w)}; }
                const f32x4 g0 = ((const f32x4*)pgate)[2 * (F.lane + 64 * j)], g1 = ((const f32x4*)pgate)[2 * (F.lane + 64 * j) + 1];
                v[j][0] += g0.x * a0.x; v[j][1] += g0.y * a0.y; v[j][2] += g0.z * a0.z; v[j][3] += g0.w * a0.w; v[j][4] += g1.x * a1.x; v[j][5] += g1.y * a1.y; v[j][6] += g1.z * a1.z; v[j][7] += g1.w * a1.w; }
        }
#pragma unroll
        for (int j = 0; j < 4; ++j)
#pragma unroll
            for (int e = 0; e < 8; ++e) ss += v[j][e] * v[j][e];
        if (wr_xr) {
#pragma unroll
            for (int j = 0; j < 4; ++j) { v4u w; w.x = pk2(v[j][0], v[j][1]); w.y = pk2(v[j][2], v[j][3]); w.z = pk2(v[j][4], v[j][5]); w.w = pk2(v[j][6], v[j][7]); ((v4u*)(XR + (size_t)row * D))[F.lane + 64 * j] = w; }
        }
        const float rs = 1.0f / sqrtf(wave_sum(ss) * (1.0f / D) + EPS);
        if (KIND == 2) {
#pragma unroll
            for (int j = 0; j < 4; ++j) { const f32x4 w0 = ((const f32x4*)nw)[2 * (F.lane + 64 * j)], w1 = ((const f32x4*)nw)[2 * (F.lane + 64 * j) + 1];
                f32x4 o0 = {v[j][0] * rs * w0.x, v[j][1] * rs * w0.y, v[j][2] * rs * w0.z, v[j][3] * rs * w0.w}, o1 = {v[j][4] * rs * w1.x, v[j][5] * rs * w1.y, v[j][6] * rs * w1.z, v[j][7] * rs * w1.w};
                ((f32x4*)(P.out + (size_t)row * D))[2 * (F.lane + 64 * j)] = o0; ((f32x4*)(P.out + (size_t)row * D))[2 * (F.lane + 64 * j) + 1] = o1; }
        } else {
            const int brow = row < ML ? (row >> 12) : 4;
            const float* mb = MOD + (size_t)(l * 5 + brow) * NMOD + (KIND == 0 ? 0 : 6144);
#pragma unroll
            for (int j = 0; j < 4; ++j) { float y[8];
#pragma unroll
                for (int h = 0; h < 2; ++h) { const int q = 2 * (F.lane + 64 * j) + h; const f32x4 w = ((const f32x4*)nw)[q], sh = ((const f32x4*)mb)[q], sc = ((const f32x4*)(mb + 2048))[q];
                    y[4 * h + 0] = (v[j][4 * h + 0] * rs * w.x) * (sc.x + 1.0f) + sh.x; y[4 * h + 1] = (v[j][4 * h + 1] * rs * w.y) * (sc.y + 1.0f) + sh.y;
                    y[4 * h + 2] = (v[j][4 * h + 2] * rs * w.z) * (sc.z + 1.0f) + sh.z; y[4 * h + 3] = (v[j][4 * h + 3] * rs * w.w) * (sc.w + 1.0f) + sh.w; }
                v4u o; o.x = pk2(y[0], y[1]); o.y = pk2(y[2], y[3]); o.z = pk2(y[4], y[5]); o.w = pk2(y[6], y[7]); ((v4u*)(XN + (size_t)row * D))[F.lane + 64 * j] = o; }
        }
    }
}

typedef short bf16x8_t __attribute__((ext_vector_type(8)));
__device__ __forceinline__ void dt_phase_part(const Params& P, Frame& F, int l) {
    unsigned char* ws = P.ws;
    const bf16* XN = (const bf16*)(ws + WS_XN); const bf16* Wd = (const bf16*)(ws + WS_WIN) + ((size_t)l * PROJP + 5632) * D; float* DTo = (float*)(ws + WS_DT);
    constexpr int ARS = 2056;
    LAS bf16* At = (LAS bf16*)F.lds; LAS float* red = (LAS float*)(F.lds + 16 * ARS * 2);
    const int lc = F.lane & 15, q4 = F.lane >> 4, w = F.wave;
    bf16x8_t b0v[8], b1v[8];
    { const bf16* bp = Wd + (size_t)lc * D + 256 * w + 8 * q4;
#pragma unroll
      for (int e = 0; e < 8; ++e) { b0v[e] = *(const bf16x8_t*)(bp + 32 * e); b1v[e] = *(const bf16x8_t*)(bp + 16 * D + 32 * e); } }
    v4u tmp[8];
    if (F.bid < MROWS / 16) {
#pragma unroll
        for (int i = 0; i < 8; ++i) { const int q = F.tid + 512 * i; tmp[i] = *(const v4u*)(XN + (size_t)(F.bid * 16 + (q >> 8)) * D + 8 * (q & 255)); } }
    for (int rt = F.bid; rt < MROWS / 16; rt += F.G) {
        __syncthreads();
#pragma unroll
        for (int i = 0; i < 8; ++i) { const int q = F.tid + 512 * i; *(LAS v4u*)(At + (q >> 8) * ARS + 8 * (q & 255)) = tmp[i]; }
        if (rt + F.G < MROWS / 16) {
#pragma unroll
            for (int i = 0; i < 8; ++i) { const int q = F.tid + 512 * i; tmp[i] = *(const v4u*)(XN + (size_t)((rt + F.G) * 16 + (q >> 8)) * D + 8 * (q & 255)); } }
        __syncthreads();
        f32x4 a0 = {0.f, 0.f, 0.f, 0.f}, a1 = a0;
#pragma unroll
        for (int e = 0; e < 8; ++e) { const bf16x8_t a = *(const LAS bf16x8_t*)(At + lc * ARS + 256 * w + 32 * e + 8 * q4);
            a0 = __builtin_amdgcn_mfma_f32_16x16x32_bf16(a, b0v[e], a0, 0, 0, 0); a1 = __builtin_amdgcn_mfma_f32_16x16x32_bf16(a, b1v[e], a1, 0, 0, 0); }
#pragma unroll
        for (int r = 0; r < 4; ++r) { red[w * 512 + (4 * q4 + r) * 32 + lc] = a0[r]; red[w * 512 + (4 * q4 + r) * 32 + 16 + lc] = a1[r]; }
        __syncthreads();
        { float sacc = 0.f;
#pragma unroll
          for (int ww = 0; ww < 8; ++ww) sacc += red[ww * 512 + F.tid];
          DTo[(size_t)(rt * 16) * 32 + F.tid] = sacc; }
    }
    __syncthreads();
}
__device__ __forceinline__ void xbc_conv_phase(const Params& P, Frame& F, int l) {
    unsigned char* ws = P.ws;
    dt_phase_part(P, F, l);
#ifdef REP_DT
    dt_phase_part(P, F, l);
#endif
    const bf16* XBC = (const bf16*)(ws + WS_XBC); bf16* XBCC = (bf16*)(ws + WS_XBCC);
    const float* cw = P.in[I_SCW] + (size_t)l * 3 * XBCW; const float* cb = P.in[I_SCB] + (size_t)l * XBCW;
    if (F.tid < 384) {
        const int ch = F.tid % 192, half = F.tid / 192, c0 = ch * 8;
        float w0[8], w1[8], w2[8], bb[8];
#pragma unroll
        for (int e = 0; e < 8; ++e) { w0[e] = cw[c0 + e]; w1[e] = cw[XBCW + c0 + e]; w2[e] = cw[2 * XBCW + c0 + e]; bb[e] = cb[c0 + e]; }
        const v4u z = {0u, 0u, 0u, 0u};
        for (int it = F.bid; it < MROWS / 68; it += F.G) {
            const int r0 = it * 68 + half * 34;
            v4u R[36];
#pragma unroll
            for (int k = 0; k < 36; ++k) { int rr = r0 - 1 + k; rr = rr < 0 ? 0 : (rr >= MROWS ? MROWS - 1 : rr); R[k] = *(const v4u*)(XBC + (size_t)rr * XBCW + c0); }
#pragma unroll
            for (int i = 0; i < 34; ++i) {
                const int row = r0 + i; const int seqmask = row < ML ? 63 : 255, rel = row < ML ? row : row - ML;
                const bool hn = ((rel & seqmask) != seqmask), hp = ((rel & seqmask) != 0);
                const v4u prev = hp ? R[i] : z, cur = R[i + 1], nx = hn ? R[i + 2] : z;
                float o[8];
#pragma unroll
                for (int q = 0; q < 4; ++q) {
                    const float ya = bb[2 * q] + w0[2 * q] * bflo(prev[q]) + w1[2 * q] * bflo(cur[q]) + w2[2 * q] * bflo(nx[q]);
                    const float yb = bb[2 * q + 1] + w0[2 * q + 1] * bfhi(prev[q]) + w1[2 * q + 1] * bfhi(cur[q]) + w2[2 * q + 1] * bfhi(nx[q]);
                    o[2 * q] = silu_f(ya); o[2 * q + 1] = silu_f(yb); }
                v4u w; w.x = pk2(o[0], o[1]); w.y = pk2(o[2], o[3]); w.z = pk2(o[4], o[5]); w.w = pk2(o[6], o[7]);
                *(v4u*)(XBCC + (size_t)row * XBCW + c0) = w;
            }
        }
    }
}

__device__ __forceinline__ void ssd_naive_item(const Params& P, Frame& F, int l, int item) {
    unsigned char* ws = P.ws;
    const bf16* XBCC = (const bf16*)(ws + WS_XBCC); const float* DT = (const float*)(ws + WS_DT);
    const int b = item >> 5, h = (item >> 1) & 15, d = item & 1, g = h >> 3;
    float* Yo = (float*)(ws + (d ? WS_YB : WS_YF));
    const float A = -expf(P.in[I_ALOG][l * 32 + d * 16 + h]), dtb = P.in[I_DTB][l * 32 + d * 16 + h];
    LAS float* xs = (LAS float*)F.lds;
    LAS float* Bs = xs + 2048;
    LAS float* Cs = Bs + 4096;
    LAS float* ys = Cs + 4096;
    LAS float* dts = ys + 2048;
    LAS float* das = dts + 32;
    const int p = F.tid >> 3, nq = F.tid & 7;
    float S[16];
#pragma unroll
    for (int j = 0; j < 16; ++j) S[j] = 0.f;
    for (int seg = 0; seg < 2; ++seg) {
        const int base_row = seg == 0 ? ML + b * CTX : b * SEQ, L = seg == 0 ? CTX : SEQ;
        for (int blk = 0; blk < L / 32; ++blk) {
            { const int i = F.tid >> 4, q = F.tid & 15; const int pos = blk * 32 + i; const int t = d ? (L - 1 - pos) : pos; const size_t row = (size_t)(base_row + t);
              const v2u xr = *(const v2u*)(XBCC + row * XBCW + h * 64 + 4 * q);
              xs[i * 64 + 4 * q + 0] = bflo(xr.x); xs[i * 64 + 4 * q + 1] = bfhi(xr.x); xs[i * 64 + 4 * q + 2] = bflo(xr.y); xs[i * 64 + 4 * q + 3] = bfhi(xr.y);
              const v4u br = *(const v4u*)(XBCC + row * XBCW + 1024 + g * 128 + 8 * q); const v4u cr = *(const v4u*)(XBCC + row * XBCW + 1280 + g * 128 + 8 * q);
#pragma unroll
              for (int e = 0; e < 4; ++e) { Bs[i * 128 + 8 * q + 2 * e] = bflo(br[e]); Bs[i * 128 + 8 * q + 2 * e + 1] = bfhi(br[e]); Cs[i * 128 + 8 * q + 2 * e] = bflo(cr[e]); Cs[i * 128 + 8 * q + 2 * e + 1] = bfhi(cr[e]); }
              if (F.tid < 32) { const int pos2 = blk * 32 + F.tid; const int t2 = d ? (L - 1 - pos2) : pos2; const float dt = softplus_f(DT[(size_t)(base_row + t2) * 32 + d * 16 + h] + dtb); dts[F.tid] = dt; das[F.tid] = expf(dt * A); } }
            __syncthreads();
            for (int i = 0; i < 32; ++i) {
                const float dA = das[i], xdt = xs[i * 64 + p] * dts[i]; float acc = 0.f;
#pragma unroll
                for (int j = 0; j < 16; ++j) { S[j] = S[j] * dA + xdt * Bs[i * 128 + nq * 16 + j]; acc += Cs[i * 128 + nq * 16 + j] * S[j]; }
                acc += __shfl_xor(acc, 1); acc += __shfl_xor(acc, 2); acc += __shfl_xor(acc, 4);
                if (nq == 0) ys[i * 64 + p] = acc;
            }
            __syncthreads();
            { const int i = F.tid >> 4, q = F.tid & 15; const int pos = blk * 32 + i; const int t = d ? (L - 1 - pos) : pos; const size_t row = (size_t)(base_row + t);
              *(f32x4*)(Yo + row * SSDW + h * 64 + 4 * q) = *(LAS f32x4*)(ys + i * 64 + 4 * q); }
        }
    }
    __syncthreads();
}

__device__ __forceinline__ float block_sum(Frame& F, LAS float* red, float v) {
    v = wave_sum(v);
    __syncthreads();
    if (F.lane == 0) red[F.wave] = v;
    __syncthreads();
    float s = 0.f;
#pragma unroll
    for (int w = 0; w < NWAVES; ++w) s += red[w];
    return s;
}

__device__ __forceinline__ void hyena_lat_naive_item(const Params& P, Frame& F, int l, int c) {
    unsigned char* ws = P.ws;
    const bf16* UT = (const bf16*)(ws + WS_UTL); bf16* ZT = (bf16*)(ws + WS_ZTL); const float* HL = (const float*)(ws + WS_HDNL) + (size_t)l * 64 * 4096;
    LAS float* kk0 = (LAS float*)F.lds; LAS float* kk1 = kk0 + 8192; LAS float* vb = kk1 + 8192; LAS float* x1b = vb + 4096; LAS float* x2b = x1b + 4096; LAS float* zb = x2b + 4096;
    LAS float* red = zb + 4096; LAS float* fw3s = red + 16;
    if (F.tid < 256) { const int q = F.tid >> 6, j = F.tid & 63; fw3s[F.tid] = P.in[I_FW3][((size_t)l * 64 + j) * 4096 + (q >> 1) * 2048 + (q & 1) * 1024 + c]; }
    __syncthreads();
    const float d0 = -3.0701134573253945f, d1 = -15.350567286626973f;
    const float adelta = fabsf(d0 + (float)c * ((d1 - d0) / 1023.0f));
    float s0 = 0.f, s1 = 0.f;
    for (int i = 0; i < 16; ++i) {
        const int idx = F.tid + 512 * i; float h0 = 0.f, h1 = 0.f;
        if (idx != 4096) { const int dir = idx > 4096 ? 1 : 0; const int t = dir ? 8192 - idx : idx;
#pragma unroll 8
            for (int j = 0; j < 64; ++j) { const float hv = HL[(size_t)j * 4096 + t]; h0 += hv * fw3s[dir * 64 + j]; h1 += hv * fw3s[(2 + dir) * 64 + j]; }
            const float win = expf(-((float)t / 4095.0f) * adelta); h0 *= win; h1 *= win; }
        kk0[idx] = h0; kk1[idx] = h1; s0 += fabsf(h0); s1 += fabsf(h1);
    }
    const float inv0 = 1.0f / (block_sum(F, red, s0) + EPS); const float inv1 = 1.0f / (block_sum(F, red, s1) + EPS);
    for (int i = 0; i < 16; ++i) { const int idx = F.tid + 512 * i; kk0[idx] *= inv0; kk1[idx] *= inv1; }
    const float hb0 = P.in[I_HBIAS][l * 2048 + c], hb1 = P.in[I_HBIAS][l * 2048 + 1024 + c];
    float cw[3][3], cbv[3];
#pragma unroll
    for (int o = 0; o < 3; ++o) { cbv[o] = P.in[I_HCB][l * HYP + o * 1024 + c];
#pragma unroll
        for (int k = 0; k < 3; ++k) cw[o][k] = P.in[I_HCW][((size_t)l * 3 + k) * HYP + o * 1024 + c]; }
    for (int b = 0; b < NB; ++b) {
        __syncthreads();
#pragma unroll
        for (int o = 0; o < 3; ++o) { const bf16* src = UT + ((size_t)b * HYP + o * 1024 + c) * SEQ; LAS float* dst = o == 0 ? vb : (o == 1 ? x1b : x2b);
            for (int i = 0; i < 8; ++i) { const int t = F.tid + 512 * i; const float uc = bf2f(src[t]); const float up = (t & 63) != 0 ? bf2f(src[t - 1]) : 0.f; const float un = (t & 63) != 63 ? bf2f(src[t + 1]) : 0.f;
                dst[t] = cbv[o] + cw[o][0] * up + cw[o][1] * uc + cw[o][2] * un; } }
        __syncthreads();
        float y[8];
#pragma unroll
        for (int i = 0; i < 8; ++i) y[i] = 0.f;
        for (int s = 0; s < SEQ; ++s) { const float zs = vb[s];
#pragma unroll
            for (int i = 0; i < 8; ++i) y[i] += kk0[(F.tid + 512 * i - s) & 8191] * zs; }
#pragma unroll
        for (int i = 0; i < 8; ++i) { const int t = F.tid + 512 * i; const float z0 = vb[t]; zb[t] = x1b[t] * (y[i] + z0 * hb0); y[i] = 0.f; }
        __syncthreads();
        for (int s = 0; s < SEQ; ++s) { const float zs = zb[s];
#pragma unroll
            for (int i = 0; i < 8; ++i) y[i] += kk1[(F.tid + 512 * i - s) & 8191] * zs; }
        bf16* dstz = ZT + ((size_t)b * HYW + c) * SEQ;
#pragma unroll
        for (int i = 0; i < 8; ++i) { const int t = F.tid + 512 * i; const float z2 = x2b[t] * (y[i] + zb[t] * hb1); dstz[t] = (bf16)f2bf(z2); }
    }
    __syncthreads();
}

__device__ __forceinline__ void hyena_ctx_item(const Params& P, Frame& F, int l, int c) {
    unsigned char* ws = P.ws;
    const bf16* UT = (const bf16*)(ws + WS_UTC); bf16* ZT = (bf16*)(ws + WS_ZTC); const float* HC = (const float*)(ws + WS_HDNC) + (size_t)l * 64 * 256;
    LAS float* kk0 = (LAS float*)F.lds; LAS float* kk1 = kk0 + 512; LAS float* vb = kk1 + 512; LAS float* x1b = vb + 256; LAS float* x2b = x1b + 256; LAS float* zb = x2b + 256;
    LAS float* red = zb + 256; LAS float* fw3s = red + 16;
    if (F.tid < 256) { const int q = F.tid >> 6, j = F.tid & 63; fw3s[F.tid] = P.in[I_FW3][((size_t)l * 64 + j) * 4096 + (q >> 1) * 2048 + (q & 1) * 1024 + c]; }
    __syncthreads();
    const float d0 = -3.0701134573253945f, d1 = -15.350567286626973f;
    const float adelta = fabsf(d0 + (float)c * ((d1 - d0) / 1023.0f));
    float h0 = 0.f, h1 = 0.f;
    { const int idx = F.tid;
      if (idx != 256) { const int dir = idx > 256 ? 1 : 0; const int t = dir ? 512 - idx : idx;
#pragma unroll 8
          for (int j = 0; j < 64; ++j) { const float hv = HC[j * 256 + t]; h0 += hv * fw3s[dir * 64 + j]; h1 += hv * fw3s[(2 + dir) * 64 + j]; }
          const float win = expf(-((float)t / 255.0f) * adelta); h0 *= win; h1 *= win; } }
    const float inv0 = 1.0f / (block_sum(F, red, fabsf(h0)) + EPS); const float inv1 = 1.0f / (block_sum(F, red, fabsf(h1)) + EPS);
    kk0[F.tid] = h0 * inv0; kk1[F.tid] = h1 * inv1;
    const float hb0 = P.in[I_HBIAS][l * 2048 + c], hb1 = P.in[I_HBIAS][l * 2048 + 1024 + c];
    for (int b = 0; b < NB; ++b) {
        __syncthreads();
        if (F.tid < 256) { const int t = F.tid;
#pragma unroll
            for (int o = 0; o < 3; ++o) { const bf16* src = UT + ((size_t)b * HYP + o * 1024 + c) * CTX; LAS float* dst = o == 0 ? vb : (o == 1 ? x1b : x2b);
                const float uc = bf2f(src[t]); const float up = t != 0 ? bf2f(src[t - 1]) : 0.f; const float un = t != 255 ? bf2f(src[t + 1]) : 0.f;
                dst[t] = P.in[I_HCB][l * HYP + o * 1024 + c] + P.in[I_HCW][((size_t)l * 3 + 0) * HYP + o * 1024 + c] * up + P.in[I_HCW][((size_t)l * 3 + 1) * HYP + o * 1024 + c] * uc + P.in[I_HCW][((size_t)l * 3 + 2) * HYP + o * 1024 + c] * un; } }
        __syncthreads();
        float y = 0.f; const int t = F.tid & 255;
        if (F.tid < 256) { for (int s = 0; s < CTX; ++s) y += kk0[(t - s) & 511] * vb[s]; zb[t] = x1b[t] * (y + vb[t] * hb0); }
        __syncthreads();
        if (F.tid < 256) { y = 0.f; for (int s = 0; s < CTX; ++s) y += kk1[(t - s) & 511] * zb[s]; const float z2 = x2b[t] * (y + zb[t] * hb1); ZT[((size_t)b * HYW + c) * CTX + t] = (bf16)f2bf(z2); }
    }
    __syncthreads();
}

__device__ __forceinline__ void hyena_ctx_item2(const Params& P, Frame& Fin, int l, int c) {
    Frame F = Fin; asm volatile("" : "+v"(F.tid), "+v"(F.lane));
    unsigned char* ws = P.ws;
    const bf16* UT = (const bf16*)(ws + WS_UTC); bf16* ZT = (bf16*)(ws + WS_ZTC); const float* HC = (const float*)(ws + WS_HDNC) + (size_t)l * 64 * 256;
    LAS float* kl0 = (LAS float*)F.lds; LAS float* kl1 = kl0 + 512;
    LAS float* vb = kl1 + 512; LAS float* x1b = vb + 1024; LAS float* x2b = x1b + 1024; LAS float* zb = x2b + 1024;
    LAS float* part = zb + 1024;
    LAS float* red = part + 1024; LAS float* fw3s = red + 16;
    float fw3v = 0.f; if (F.tid < 256) { const int q = F.tid >> 6, j = F.tid & 63; fw3v = P.in[I_FW3][((size_t)l * 64 + j) * 4096 + (q >> 1) * 2048 + (q & 1) * 1024 + c]; }
    float hv[64]; const int idx = F.tid, dir = idx < 255 ? 1 : 0; const int tl = idx == 511 ? 0 : (dir ? 255 - idx : idx - 255);
#pragma unroll
    for (int j = 0; j < 64; ++j) hv[j] = HC[j * 256 + tl];
    unsigned short uraw[2][3][3];
    { const int t = F.tid & 255;
#pragma unroll
      for (int bb = 0; bb < 2; ++bb) { const int b = (F.tid >> 8) + 2 * bb;
#pragma unroll
          for (int o = 0; o < 3; ++o) { const bf16* src = UT + ((size_t)b * HYP + o * 1024 + c) * CTX; uraw[bb][o][0] = src[t]; uraw[bb][o][1] = t != 0 ? src[t - 1] : (unsigned short)0; uraw[bb][o][2] = t != 255 ? src[t + 1] : (unsigned short)0; } } }
    __syncthreads();
    if (F.tid < 256) fw3s[F.tid] = fw3v;
    __syncthreads();
    const float d0 = -3.0701134573253945f, d1v = -15.350567286626973f;
    const float adelta = fabsf(d0 + (float)c * ((d1v - d0) / 1023.0f));
    float h0 = 0.f, h1 = 0.f;
    { if (idx != 511) { const int t = tl;
#pragma unroll
          for (int j = 0; j < 64; ++j) { h0 += hv[j] * fw3s[dir * 64 + j]; h1 += hv[j] * fw3s[(2 + dir) * 64 + j]; }
          const float win = expf(-((float)t / 255.0f) * adelta); h0 *= win; h1 *= win; } }
    const float inv0 = 1.0f / (block_sum(F, red, fabsf(h0)) + EPS); const float inv1 = 1.0f / (block_sum(F, red, fabsf(h1)) + EPS);
    kl0[F.tid] = h0 * inv0; kl1[F.tid] = h1 * inv1;
    const float hb0 = P.in[I_HBIAS][l * 2048 + c], hb1 = P.in[I_HBIAS][l * 2048 + 1024 + c];
    { const int t = F.tid & 255;
#pragma unroll
      for (int bb = 0; bb < 2; ++bb) { const int b = (F.tid >> 8) + 2 * bb;
#pragma unroll
          for (int o = 0; o < 3; ++o) { const bf16* src = UT + ((size_t)b * HYP + o * 1024 + c) * CTX; LAS float* dst = (o == 0 ? vb : (o == 1 ? x1b : x2b)) + b * 256;
              const float uc = bf2f(uraw[bb][o][0]), up = bf2f(uraw[bb][o][1]), un = bf2f(uraw[bb][o][2]); (void)src;
              dst[t] = P.in[I_HCB][l * HYP + o * 1024 + c] + P.in[I_HCW][((size_t)l * 3 + 0) * HYP + o * 1024 + c] * up + P.in[I_HCW][((size_t)l * 3 + 1) * HYP + o * 1024 + c] * uc + P.in[I_HCW][((size_t)l * 3 + 2) * HYP + o * 1024 + c] * un; } } }
    __syncthreads();
    const int b = F.tid >> 7, r = F.tid & 127, tq = r & 63, sh = r >> 6, t0 = 4 * tq;
#pragma unroll
    for (int o = 0; o < 2; ++o) {
        const LAS float* kl = o ? kl1 : kl0; const LAS float* zin = (o ? zb : vb) + b * 256; const LAS float* xg = (o ? x2b : x1b) + b * 256; const float hb = o ? hb1 : hb0;
        float y[4] = {0.f, 0.f, 0.f, 0.f};
#pragma unroll 4
        for (int st = 0; st < 32; ++st) { const int s0 = 128 * sh + 4 * st; const f32x4 v4 = *(const LAS f32x4*)(zin + s0); const LAS float* kb = kl + (t0 - s0 + 252);
            const f32x4 ka = *(const LAS f32x4*)kb, kc = *(const LAS f32x4*)(kb + 4); const float kw[8] = {ka[0], ka[1], ka[2], ka[3], kc[0], kc[1], kc[2], kc[3]};
#pragma unroll
            for (int i = 0; i < 4; ++i)
#pragma unroll
                for (int e = 0; e < 4; ++e) y[i] += v4[e] * kw[i - e + 3]; }
        if (sh) *(LAS f32x4*)(part + (b * 64 + tq) * 4) = (f32x4){y[0], y[1], y[2], y[3]};
        __syncthreads();
        if (!sh) { const f32x4 pp = *(const LAS f32x4*)(part + (b * 64 + tq) * 4); const f32x4 zi = *(const LAS f32x4*)(zin + t0), xv = *(const LAS f32x4*)(xg + t0);
            f32x4 z;
#pragma unroll
            for (int i = 0; i < 4; ++i) z[i] = xv[i] * (y[i] + pp[i] + zi[i] * hb);
            if (o == 0) *(LAS f32x4*)(zb + b * 256 + t0) = z; else { v2u w; w.x = pk2(z[0], z[1]); w.y = pk2(z[2], z[3]); *(v2u*)(ZT + ((size_t)b * HYW + c) * CTX + t0) = w; } }
        __syncthreads();
    }
}

typedef float c32 __attribute__((ext_vector_type(2)));
__device__ __forceinline__ c32 cmul(c32 a, c32 b) { c32 r;
    asm("v_pk_mul_f32 %0, %1, %2 op_sel:[0,0] op_sel_hi:[0,1]\n\tv_pk_fma_f32 %0, %2, %1, %0 op_sel:[1,1,0] op_sel_hi:[0,1,1] neg_lo:[1,0,0]" : "=&v"(r) : "v"(a), "v"(b)); return r; }
__device__ __forceinline__ c32 cmulc(c32 a, c32 b) { c32 r;
    asm("v_pk_mul_f32 %0, %1, %2 op_sel:[0,0] op_sel_hi:[0,1]\n\tv_pk_fma_f32 %0, %2, %1, %0 op_sel:[1,1,0] op_sel_hi:[0,1,1] neg_hi:[0,0,1]" : "=&v"(r) : "v"(a), "v"(b)); return r; }
__device__ __forceinline__ c32 cmul_k(c32 a, c32 k) { c32 r;
    asm("v_pk_mul_f32 %0, %1, %2 op_sel:[0,0] op_sel_hi:[0,1]\n\tv_pk_fma_f32 %0, %2, %1, %0 op_sel:[1,1,0] op_sel_hi:[0,1,1] neg_lo:[1,0,0]" : "=&v"(r) : "v"(a), "s"(k)); return r; }
__device__ __forceinline__ c32 rot_add(c32 a, c32 b) { c32 r; asm("v_pk_add_f32 %0, %1, %2 op_sel:[1,0] op_sel_hi:[0,1] neg_lo:[1,0]" : "=v"(r) : "v"(b), "v"(a)); return r; }
__device__ __forceinline__ c32 rot_sub(c32 a, c32 b) { c32 r; asm("v_pk_add_f32 %0, %1, %2 op_sel:[1,0] op_sel_hi:[0,1] neg_hi:[1,0]" : "=v"(r) : "v"(b), "v"(a)); return r; }
template <bool INV> __device__ __forceinline__ c32 ctw(c32 v, float wr, float wi) { const float s = INV ? -wi : wi;
    if (wr == 0.f) return (c32){-v.y * s, v.x * s};
    return cmul_k(v, (c32){wr, s}); }
template <bool INV> __device__ __forceinline__ void dft4(c32& a, c32& b, c32& c, c32& d) {
    const c32 s02 = a + c, d02 = a - c, s13 = b + d, d13 = b - d;
    a = s02 + s13; c = s02 - s13;
    if (INV) { b = rot_add(d02, d13); d = rot_sub(d02, d13); }
    else { b = rot_sub(d02, d13); d = rot_add(d02, d13); }
}
template <bool INV> __device__ __forceinline__ void dft16(c32 (&x)[16]) {
    constexpr float C1 = 0.92387953251128674f, S1 = 0.38268343236508977f, R2 = 0.70710678118654752f;
#pragma unroll
    for (int a0 = 0; a0 < 4; ++a0) dft4<INV>(x[a0], x[4 + a0], x[8 + a0], x[12 + a0]);
    x[5] = ctw<INV>(x[5], C1, -S1);  x[6] = ctw<INV>(x[6], R2, -R2);   x[7] = ctw<INV>(x[7], S1, -C1);
    x[9] = ctw<INV>(x[9], R2, -R2);  x[10] = ctw<INV>(x[10], 0.f, -1.f); x[11] = ctw<INV>(x[11], -R2, -R2);
    x[13] = ctw<INV>(x[13], S1, -C1); x[14] = ctw<INV>(x[14], -R2, -R2); x[15] = ctw<INV>(x[15], -C1, S1);
#pragma unroll
    for (int d0 = 0; d0 < 4; ++d0) dft4<INV>(x[4 * d0], x[4 * d0 + 1], x[4 * d0 + 2], x[4 * d0 + 3]);
    c32 y[16];
#pragma unroll
    for (int d0 = 0; d0 < 4; ++d0)
#pragma unroll
        for (int d1 = 0; d1 < 4; ++d1) y[d0 + 4 * d1] = x[4 * d0 + d1];
#pragma unroll
    for (int i = 0; i < 16; ++i) x[i] = y[i];
}
template <bool INV> __device__ __forceinline__ void apply_pow(c32 (&r)[16], c32 w) {
    if (INV) w.y = -w.y;
    const c32 p2 = cmul(w, w), p3 = cmul(p2, w), p4 = cmul(p2, p2), p5 = cmul(p4, w), p6 = cmul(p3, p3), p7 = cmul(p4, p3), p8 = cmul(p4, p4);
    r[1] = cmul(r[1], w); r[2] = cmul(r[2], p2); r[3] = cmul(r[3], p3); r[4] = cmul(r[4], p4); r[5] = cmul(r[5], p5); r[6] = cmul(r[6], p6); r[7] = cmul(r[7], p7); r[8] = cmul(r[8], p8);
    r[9] = cmul(r[9], cmul(p8, w)); r[10] = cmul(r[10], cmul(p5, p5)); r[11] = cmul(r[11], cmul(p8, p3)); r[12] = cmul(r[12], cmul(p6, p6));
    r[13] = cmul(r[13], cmul(p8, p5)); r[14] = cmul(r[14], cmul(p7, p7)); r[15] = cmul(r[15], cmul(p8, p7));
}
constexpr int TWROW = 18, TW_OFF = 102400, TW_BYTES = (256 + 16) * TWROW * 8;
template <bool INV> __device__ __forceinline__ void apply_tab(c32 (&r)[16], const LAS c32* row) {
    asm volatile("" : "+v"(row));
    f32x4 q[8];
#pragma unroll
    for (int i = 0; i < 8; ++i) q[i] = *(const LAS f32x4*)(row + 2 * i);
    r[1] = INV ? cmulc(r[1], (c32){q[0].z, q[0].w}) : cmul(r[1], (c32){q[0].z, q[0].w});
#pragma unroll
    for (int i = 1; i < 8; ++i) { const c32 w0 = {q[i].x, q[i].y}, w1 = {q[i].z, q[i].w};
        r[2 * i] = INV ? cmulc(r[2 * i], w0) : cmul(r[2 * i], w0); r[2 * i + 1] = INV ? cmulc(r[2 * i + 1], w1) : cmul(r[2 * i + 1], w1); }
}
__device__ __forceinline__ void fft_tables_build(LAS unsigned char* lds, int tid) {
    LAS c32* tw = (LAS c32*)(lds + TW_OFF);
    for (int i = tid; i < 272 * 16; i += NTHR) { const int row = i >> 4, d = i & 15; float sn, cs;
        if (row < 256) sincospif((float)((row * d) & 4095) * (1.0f / 2048.0f), &sn, &cs); else sincospif((float)(((row - 256) * d) & 255) * (1.0f / 128.0f), &sn, &cs);
        tw[row * TWROW + d] = (c32){cs, -sn}; }
}
#define LAUNDER_C32(v) asm volatile("" : "+v"((v).x), "+v"((v).y))
#define FFT_WAVE_SYNC() asm volatile("s_waitcnt lgkmcnt(0)" ::: "memory")
struct FftThr { int u, d1, lo, g2; c32 wA, wB, wu; const LAS c32* ra; const LAS c32* rb; };
__device__ __forceinline__ c32 w32(int a) {
    constexpr float C[16] = {1.f, 0.98078528040323043f, 0.92387953251128674f, 0.83146961230254524f, 0.70710678118654752f, 0.55557023301960218f, 0.38268343236508977f, 0.19509032201612825f,
                             0.f, -0.19509032201612825f, -0.38268343236508977f, -0.55557023301960218f, -0.70710678118654752f, -0.83146961230254524f, -0.92387953251128674f, -0.98078528040323043f};
    constexpr float S[16] = {0.f, 0.19509032201612825f, 0.38268343236508977f, 0.55557023301960218f, 0.70710678118654752f, 0.83146961230254524f, 0.92387953251128674f, 0.98078528040323043f,
                             1.f, 0.98078528040323043f, 0.92387953251128674f, 0.83146961230254524f, 0.70710678118654752f, 0.55557023301960218f, 0.38268343236508977f, 0.19509032201612825f};
    return (c32){C[a], -S[a]};
}
__device__ __forceinline__ void fft_fwd(c32 (&r)[16], LAS c32* xb, const FftThr& T) {
    dft16<false>(r); apply_tab<false>(r, T.ra);
    { LAS c32* p = xb + T.u + T.d1;
#pragma unroll
      for (int d = 0; d < 16; ++d) p[272 * d] = r[d]; }
    LDS_BARRIER();
    { LAS c32* p = xb + 272 * T.d1 + T.lo;
#pragma unroll
      for (int a = 0; a < 16; ++a) r[a] = p[17 * a];
      dft16<false>(r); apply_tab<false>(r, T.rb);
#pragma unroll
      for (int d = 0; d < 16; ++d) p[17 * d] = r[d]; }
    FFT_WAVE_SYNC();
    { LAS c32* p = xb + 272 * T.d1 + 17 * T.lo;
#pragma unroll
      for (int a = 0; a < 16; ++a) r[a] = p[a]; }
    dft16<false>(r);
}
__device__ __forceinline__ void fft_inv(c32 (&r)[16], LAS c32* xb, const FftThr& T) {
    dft16<true>(r);
    { LAS c32* p = xb + 272 * T.d1 + 17 * T.lo;
#pragma unroll
      for (int a = 0; a < 16; ++a) p[a] = r[a]; }
    FFT_WAVE_SYNC();
    { LAS c32* p = xb + 272 * T.d1 + T.lo;
#pragma unroll
      for (int d = 0; d < 16; ++d) r[d] = p[17 * d];
      apply_tab<true>(r, T.rb); dft16<true>(r);
#pragma unroll
      for (int a = 0; a < 16; ++a) p[17 * a] = r[a]; }
    LDS_BARRIER();
    { LAS c32* p = xb + T.u + T.d1;
#pragma unroll
      for (int d = 0; d < 16; ++d) r[d] = p[272 * d]; }
    apply_tab<true>(r, T.ra); dft16<true>(r);
}
__device__ __forceinline__ FftThr fft_thread_setup(int tid) {
    FftThr T; T.u = tid & 255; T.d1 = T.u >> 4; T.lo = T.u & 15; T.g2 = tid >> 8;
    float s, c;
    sincospif((float)T.u * (1.0f / 2048.0f), &s, &c); T.wA = (c32){c, -s};
    sincospif((float)T.lo * (1.0f / 128.0f), &s, &c); T.wB = (c32){c, -s};
    sincospif((float)T.u * (1.0f / 4096.0f), &s, &c); T.wu = (c32){c, -s};
    return T;
}

__device__ __forceinline__ void hy_conv8_load(const bf16* UT, int c, int o, int pair, int n0, v4u (&raw)[2]) {
#pragma unroll
    for (int bb = 0; bb < 2; ++bb) raw[bb] = *(const v4u*)(UT + ((size_t)(2 * pair + bb) * HYP + o * 1024 + c) * SEQ + n0);
}
__device__ __forceinline__ void hy_conv8_calc(const Params& P, int l, int c, int o, int n0, const v4u (&raw)[2], c32 (&out)[8]) {
    const float cb_ = P.in[I_HCB][l * HYP + o * 1024 + c], w0 = P.in[I_HCW][((size_t)l * 3 + 0) * HYP + o * 1024 + c], w1 = P.in[I_HCW][((size_t)l * 3 + 1) * HYP + o * 1024 + c], w2 = P.in[I_HCW][((size_t)l * 3 + 2) * HYP + o * 1024 + c];
    float val[2][8];
#pragma unroll
    for (int bb = 0; bb < 2; ++bb) {
        float x[8];
#pragma unroll
        for (int e = 0; e < 4; ++e) { x[2 * e] = bflo(raw[bb][e]); x[2 * e + 1] = bfhi(raw[bb][e]); }
        float left = __shfl_up(x[7], 1), right = __shfl_down(x[0], 1);
        if ((n0 & 63) == 0) left = 0.f;
        if ((n0 & 63) == 56) right = 0.f;
#pragma unroll
        for (int e = 0; e < 8; ++e) val[bb][e] = cb_ + w0 * (e ? x[e - 1] : left) + w1 * x[e] + w2 * (e < 7 ? x[e + 1] : right); }
#pragma unroll
    for (int e = 0; e < 8; ++e) out[e] = (c32){val[0][e], val[1][e]};
}
__device__ __forceinline__ void hy_conv8(const Params& P, const bf16* UT, int l, int c, int o, int pair, int n0, c32 (&out)[8]) {
    v4u raw[2]; hy_conv8_load(UT, c, o, pair, n0, raw); hy_conv8_calc(P, l, c, o, n0, raw, out);
}
__device__ __forceinline__ void hy_filt_calc(const float (&hv)[64], const LAS float* fw3s, int t, float adelta, float* FS, float& s0, float& s1) {
    float hq[4] = {0.f, 0.f, 0.f, 0.f};
    const LAS float* fwp = fw3s; asm volatile("" : "+v"(fwp));
#pragma unroll
    for (int j = 0; j < 64; j += 4)
#pragma unroll
        for (int q = 0; q < 4; ++q) { const f32x4 fw = *(const LAS f32x4*)(fwp + q * 64 + j);
#pragma unroll
            for (int e = 0; e < 4; ++e) hq[q] += hv[j + e] * fw[e]; }
    float h0 = hq[0], h1 = hq[1], h2 = hq[2], h3 = hq[3];
    const float win = expf(-((float)t / 4095.0f) * adelta); h0 *= win; h1 *= win; h2 *= win; h3 *= win;
    if (t == 0) { h1 = 0.f; h3 = 0.f; }
    const int tr = (4096 - t) & 4095;
    FS[t] = h0; FS[4096 + tr] = h1; FS[8192 + t] = h2; FS[12288 + tr] = h3;
    s0 += fabsf(h0) + fabsf(h1); s1 += fabsf(h2) + fabsf(h3);
}
__device__ __forceinline__ void hy_filt_calc2(const float (&hv)[64], const LAS float* fw3s, int t, float ad0, float ad1, float* FS, float (&sm)[4]) {
    const float tl = (float)t / 4095.0f; const int tr = (4096 - t) & 4095;
#pragma unroll
    for (int ch = 0; ch < 2; ++ch) {
        float hq[4] = {0.f, 0.f, 0.f, 0.f};
        const LAS float* fwp = fw3s + ch * 256; asm volatile("" : "+v"(fwp));
#pragma unroll
        for (int j = 0; j < 64; j += 4)
#pragma unroll
            for (int q = 0; q < 4; ++q) { const f32x4 fw = *(const LAS f32x4*)(fwp + q * 64 + j);
#pragma unroll
                for (int e = 0; e < 4; ++e) hq[q] += hv[j + e] * fw[e]; }
        const float win = expf(-tl * (ch ? ad1 : ad0));
        float h0 = hq[0] * win, h1 = hq[1] * win, h2 = hq[2] * win, h3 = hq[3] * win;
        if (t == 0) { h1 = 0.f; h3 = 0.f; }
        float* fs = FS + ch * 16384;
        fs[t] = h0; fs[4096 + tr] = h1; fs[8192 + t] = h2; fs[12288 + tr] = h3;
        sm[2 * ch] += fabsf(h0) + fabsf(h1); sm[2 * ch + 1] += fabsf(h2) + fabsf(h3); }
}
__device__ __forceinline__ void filter_table_part(const Params& P, Frame& F, int lf, int it0, int step) {
    unsigned char* ws = P.ws;
    const bf16* HLh = (const bf16*)(ws + WS_HDNL) + (size_t)lf * 4096 * 64; const bf16* HLl = HLh + (size_t)DEPTH * 4096 * 64;
    const bf16* FTh = (const bf16*)(ws + WS_FW3T) + (size_t)lf * 4096 * 64; const bf16* FTl = FTh + (size_t)DEPTH * 4096 * 64;
    float* FSG = (float*)(ws + WS_FSG); float* INV = (float*)(ws + WS_INV);
    LAS float* red = (LAS float*)F.lds;
    const int lc = F.lane & 15, q4 = F.lane >> 4, w = F.wave;
    const float d0 = -3.0701134573253945f, d1v = -15.350567286626973f;
    for (int it = it0; it < 256; it += step) {
        const int c0 = 4 * it;
        bf16x8_t ah[2], al[2];
        { const int col = ((lc & 3) >> 1) * 2048 + (lc & 1) * 1024 + c0 + (lc >> 2);
#pragma unroll
          for (int ks = 0; ks < 2; ++ks) { ah[ks] = *(const bf16x8_t*)(FTh + (size_t)col * 64 + 32 * ks + 8 * q4); al[ks] = *(const bf16x8_t*)(FTl + (size_t)col * 64 + 32 * ks + 8 * q4); } }
        const float ad = fabsf(d0 + (float)(c0 + q4) * ((d1v - d0) / 1023.0f)); float sab0 = 0.f, sab1 = 0.f;
        float* fs = FSG + (size_t)(c0 + q4) * 16384;
#pragma unroll 4
        for (int tt = 0; tt < 32; ++tt) {
            const int t = 512 * w + 16 * tt + lc;
            const bf16* bp = HLh + (size_t)t * 64 + 8 * q4; const bf16* bq = HLl + (size_t)t * 64 + 8 * q4;
            const bf16x8_t bh0 = *(const bf16x8_t*)bp, bh1 = *(const bf16x8_t*)(bp + 32), bl0 = *(const bf16x8_t*)bq, bl1 = *(const bf16x8_t*)(bq + 32);
            const float tl = (float)t / 4095.0f; const int tr = (4096 - t) & 4095;
            f32x4 acc = {0.f, 0.f, 0.f, 0.f};
            acc = __builtin_amdgcn_mfma_f32_16x16x32_bf16(al[0], bh0, acc, 0, 0, 0); acc = __builtin_amdgcn_mfma_f32_16x16x32_bf16(al[1], bh1, acc, 0, 0, 0);
            acc = __builtin_amdgcn_mfma_f32_16x16x32_bf16(ah[0], bl0, acc, 0, 0, 0); acc = __builtin_amdgcn_mfma_f32_16x16x32_bf16(ah[1], bl1, acc, 0, 0, 0);
            acc = __builtin_amdgcn_mfma_f32_16x16x32_bf16(ah[0], bh0, acc, 0, 0, 0); acc = __builtin_amdgcn_mfma_f32_16x16x32_bf16(ah[1], bh1, acc, 0, 0, 0);
            const float win = expf(-tl * ad);
            float h0 = acc[0] * win, h1 = acc[1] * win, h2 = acc[2] * win, h3 = acc[3] * win;
            if (t == 0) { h1 = 0.f; h3 = 0.f; }
            fs[t] = h0; fs[4096 + tr] = h1; fs[8192 + t] = h2; fs[12288 + tr] = h3;
            sab0 += fabsf(h0) + fabsf(h1); sab1 += fabsf(h2) + fabsf(h3);
        }
        __syncthreads();
#pragma unroll
        for (int o = 0; o < 2; ++o) { float v = o ? sab1 : sab0; v += __shfl_xor(v, 1); v += __shfl_xor(v, 2); v += __shfl_xor(v, 4); v += __shfl_xor(v, 8);
            if (lc == 0) red[(w * 4 + q4) * 2 + o] = v; }
        __syncthreads();
        if (F.tid < 8) { float tot = 0.f;
#pragma unroll
            for (int ww = 0; ww < 8; ++ww) tot += red[ww * 8 + F.tid];
            INV[c0 * 2 + F.tid] = 1.0f / (tot + EPS); }
    }
    __syncthreads();
}
__device__ __forceinline__ void hyena_fft_item(const Params& P, Frame& Fin, int l, int c, const FftThr& Tin, int& tw_ok) {
    Frame F = Fin; asm volatile("" : "+v"(F.tid), "+v"(F.lane));
    FftThr T = Tin; asm volatile("" : "+v"(T.u), "+v"(T.d1), "+v"(T.lo), "+v"(T.g2)); LAUNDER_C32(T.wA); LAUNDER_C32(T.wB); LAUNDER_C32(T.wu);
    unsigned char* ws = P.ws;
    const bf16* UT = (const bf16*)(ws + WS_UTL); bf16* ZT = (bf16*)(ws + WS_ZTL);
    const float* FS = (const float*)(ws + WS_FSG) + (size_t)c * 16384;
    const float inv0 = ((const float*)(ws + WS_INV))[2 * c], inv1 = ((const float*)(ws + WS_INV))[2 * c + 1];
    c32* ZIN = (c32*)(ws + WS_ZIN) + (size_t)F.bid * 8192;
    LAS c32* XB0 = (LAS c32*)F.lds; LAS c32* XB1 = XB0 + 4352;
    LAS c32* XG = (LAS c32*)(F.lds + 69632);
    const int g2u = __builtin_amdgcn_readfirstlane(T.g2);
    LAS c32* xb = g2u ? XB1 : XB0;
    const int own = T.u + T.d1;
    const int n0 = 8 * F.tid;
    if (!tw_ok) { fft_tables_build(F.lds, F.tid); tw_ok = 1; }
    T.ra = (const LAS c32*)(F.lds + TW_OFF) + T.u * TWROW; T.rb = (const LAS c32*)(F.lds + TW_OFF) + (256 + T.lo) * TWROW;
    __syncthreads();
    {
    c32 K[16]; v4u graw[2];
    { v4u raw0[2], raw1[2]; hy_conv8_load(UT, c, 0, 0, n0, raw0); hy_conv8_load(UT, c, 0, 1, n0, raw1); hy_conv8_load(UT, c, 1, 0, n0, graw);
      c32 v8[8]; hy_conv8_calc(P, l, c, 0, n0, raw0, v8);
#pragma unroll
      for (int e = 0; e < 8; ++e) ZIN[n0 + e] = v8[e];
      hy_conv8_calc(P, l, c, 0, n0, raw1, v8);
#pragma unroll
      for (int e = 0; e < 8; ++e) ZIN[4096 + n0 + e] = v8[e]; }
    __syncthreads();
#pragma unroll 1
    for (int it = 0; it < 4; ++it) {
        const int o = it >> 1, pair = it & 1;
        if (pair == 0) {
            c32 r[16]; const float* hf = FS + o * 8192 + T.u; c32 wl = T.wu; LAUNDER_C32(wl);
#pragma unroll
            for (int a = 0; a < 16; ++a) { const float lov = hf[256 * a], hiv = hf[4096 + 256 * a]; r[a] = (c32){lov, hiv}; }
            if (g2u) {
#pragma unroll
                for (int a = 0; a < 16; ++a) { const c32 w = cmul_k(wl, w32(a)); const float dd = r[a].x - r[a].y; r[a] = w * dd; } }
            else {
#pragma unroll
                for (int a = 0; a < 16; ++a) r[a] = (c32){r[a].x + r[a].y, 0.f}; }
            fft_fwd(r, xb, T);
            const float sc = (o ? inv1 : inv0) * (1.0f / 8192.0f);
#pragma unroll
            for (int d = 0; d < 16; ++d) K[d] = r[d] * sc;
            __syncthreads();
        }
        const float hb = P.in[I_HBIAS][l * 2048 + o * 1024 + c];
        { c32 g8[8]; hy_conv8_calc(P, l, c, o + 1, n0, graw, g8);
#pragma unroll
          for (int e = 0; e < 8; ++e) XG[n0 + e] = g8[e]; }
        c32* zin = ZIN + pair * 4096 + T.u;
        c32 r[16], zc[16];
        { c32 wl = T.wu; LAUNDER_C32(wl);
#pragma unroll
          for (int a = 0; a < 16; ++a) zc[a] = zin[256 * a];
#pragma unroll
          for (int a = 0; a < 16; ++a) r[a] = zc[a];
          if (g2u) {
#pragma unroll
              for (int a = 0; a < 16; ++a) r[a] = cmul(zc[a], cmul_k(wl, w32(a))); } }
#ifdef REP_FFT
        { c32 rd[16];
#pragma unroll
          for (int a = 0; a < 16; ++a) rd[a] = r[a];
          fft_fwd(rd, xb, T); fft_inv(rd, xb, T);
#pragma unroll
          for (int a = 0; a < 16; ++a) asm volatile("" :: "v"(rd[a].x), "v"(rd[a].y));
          __syncthreads(); }
#endif
        fft_fwd(r, xb, T);
#pragma unroll
        for (int d = 0; d < 16; ++d) r[d] = cmul(r[d], K[d]);
        if (it < 3) {
            const int o2 = (it + 1) >> 1, p2 = (it + 1) & 1;
            hy_conv8_load(UT, c, o2 + 1, p2, n0, graw);
        }
        fft_inv(r, xb, T);
        if (g2u) { c32 wl = T.wu; LAUNDER_C32(wl);
#pragma unroll
            for (int a = 0; a < 16; ++a) { const c32 w = cmul_k(wl, w32(a)); XB1[own + 272 * a] = cmulc(r[a], w); } }
        LDS_BARRIER();
        if (!g2u) {
            bf16* z0p = ZT + ((size_t)(2 * pair) * HYW + c) * SEQ + T.u; bf16* z1p = z0p + (size_t)HYW * SEQ;
#pragma unroll
            for (int a = 0; a < 16; ++a) { const c32 y = r[a] + XB1[own + 272 * a]; const c32 x = XG[T.u + 256 * a]; r[a] = x * (y + zc[a] * hb); }
            if (o == 0) {
#pragma unroll
                for (int a = 0; a < 16; ++a) zin[256 * a] = r[a]; }
            else {
#pragma unroll
                for (int a = 0; a < 16; ++a) { const unsigned pz = pk2(r[a].x, r[a].y); z0p[256 * a] = (bf16)(pz & 0xffffu); z1p[256 * a] = (bf16)(pz >> 16); } } }
        LDS_BARRIER();
    }
    }
}

typedef short bf16x8 __attribute__((ext_vector_type(8)));
constexpr int SRS = 136;
__device__ __forceinline__ float wave_incl_scan(float s) {
#define SCAN_STEP(ctrl, rmask) s += __builtin_bit_cast(float, __builtin_amdgcn_update_dpp(0, __builtin_bit_cast(int, s), ctrl, rmask, 0xf, false))
    SCAN_STEP(0x111, 0xf); SCAN_STEP(0x112, 0xf); SCAN_STEP(0x114, 0xf); SCAN_STEP(0x118, 0xf); SCAN_STEP(0x142, 0xa); SCAN_STEP(0x143, 0xc);
#undef SCAN_STEP
    return s;
}
__device__ __forceinline__ bf16x8 ssd_frag(const LAS bf16* base, int row0, int k0, int lane) { return *(const LAS bf16x8*)(base + (row0 + (lane & 15)) * SRS + k0 + 8 * (lane >> 4)); }
__device__ __forceinline__ bf16x8 ssd_frag_sw(const LAS bf16* base, int row0, int k0, int lane, int sw) { return *(const LAS bf16x8*)(base + (row0 + (lane & 15)) * SRS + ((k0 + 8 * (lane >> 4)) ^ sw)); }
struct SsdPre { v4u c[4], b[4], x[2]; float dt0, dt1; };
__device__ __forceinline__ void ssd_prefetch(SsdPre& R, const bf16* XBCC, const float* DT, int base_row, int L, int k, int d, int h, int g, int tid, int lane) {
    const int j = tid >> 2, q = tid & 3; const int pos = 128 * k + j; const int t = d ? (L - 1 - pos) : pos; const bf16* rp = XBCC + (size_t)(base_row + t) * XBCW;
#pragma unroll
    for (int e = 0; e < 4; ++e) { R.b[e] = *(const v4u*)(rp + 1024 + g * 128 + 32 * q + 8 * e); R.c[e] = *(const v4u*)(rp + 1280 + g * 128 + 32 * q + 8 * e); }
    R.x[0] = *(const v4u*)(rp + h * 64 + 16 * q); R.x[1] = *(const v4u*)(rp + h * 64 + 16 * q + 8);
    if (tid < 64) { const int p0 = 128 * k + 2 * lane; const int t0 = d ? (L - 1 - p0) : p0, t1 = d ? (L - 2 - p0) : p0 + 1;
        R.dt0 = DT[(size_t)(base_row + t0) * 32 + d * 16 + h]; R.dt1 = DT[(size_t)(base_row + t1) * 32 + d * 16 + h]; }
}
__device__ __forceinline__ void ssd_mfma_item(const Params& P, Frame& Fin, int l, int item) {
    Frame F = Fin; asm volatile("" : "+v"(F.tid), "+v"(F.lane));
    unsigned char* ws = P.ws;
    const bf16* XBCC = (const bf16*)(ws + WS_XBCC); const float* DT = (const float*)(ws + WS_DT);
    const int b = item >> 5, h = (item >> 1) & 15, d = item & 1, g = h >> 3;
    bf16* Yo = (bf16*)(ws + (d ? WS_YB : WS_YF));
    const float A = -expf(P.in[I_ALOG][l * 32 + d * 16 + h]), dtb = P.in[I_DTB][l * 32 + d * 16 + h];
    LAS bf16* Cb = (LAS bf16*)F.lds;
    LAS bf16* Bb = Cb + 128 * SRS;
    LAS bf16* BwT = Bb + 128 * SRS;
    LAS bf16* xT = BwT + 128 * SRS;
    LAS bf16* Sb = xT + 64 * SRS;
    LAS float* acs0 = (LAS float*)(Sb + 64 * SRS);
    const int w = F.wave, lane = F.lane, q4 = lane >> 4, lc = lane & 15;
    __syncthreads();
    for (int i = F.tid; i < 64 * SRS / 2; i += NTHR) ((LAS unsigned*)Sb)[i] = 0u;
    f32x4 accs[4];
#pragma unroll
    for (int pt = 0; pt < 4; ++pt) accs[pt] = (f32x4){0.f, 0.f, 0.f, 0.f};
    SsdPre R;
    ssd_prefetch(R, XBCC, DT, ML + b * CTX, CTX, 0, d, h, g, F.tid, lane);
#define SSD_DT_SCAN(buf) do { if (F.tid < 64) { const float dt0 = softplus_f(R.dt0 + dtb), dt1 = softplus_f(R.dt1 + dtb); const float a0 = dt0 * A, a1 = dt1 * A; const float sc_ = wave_incl_scan(a0 + a1); \
        const float ae_ = __shfl(sc_, lane | 7);         \
        LAS float* ab_ = acs0 + 384 * (buf); ab_[2 * lane] = sc_ - a1; ab_[2 * lane + 1] = sc_; ab_[128 + 2 * lane] = dt0; ab_[128 + 2 * lane + 1] = dt1; \
        ab_[256 + 2 * lane] = __expf(ae_ - (sc_ - a1)) * dt0; ab_[256 + 2 * lane + 1] = __expf(ae_ - sc_) * dt1; } } while (0)
    SSD_DT_SCAN(0);
    unsigned ypk[4][2];
#define SSD_Y_STORE(ckk) do { const int sg_ = (ckk) < 2 ? 0 : 1; const int br_ = sg_ ? b * SEQ : ML + b * CTX, L_ = sg_ ? SEQ : CTX, k_ = sg_ ? (ckk) - 2 : (ckk); \
        _Pragma("unroll") for (int r = 0; r < 4; ++r) { const int pos = 128 * k_ + 16 * w + 4 * q4 + r; const int t = d ? (L_ - 1 - pos) : pos; bf16* yp = Yo + (size_t)(br_ + t) * SSDW + h * 64 + lc; \
            _Pragma("unroll") for (int pt = 0; pt < 4; ++pt) yp[16 * pt] = (bf16)((r & 1) ? (ypk[pt][r >> 1] >> 16) : (ypk[pt][r >> 1] & 0xffffu)); } } while (0)
    for (int ck = 0; ck < 34; ++ck) {
        const int seg = ck < 2 ? 0 : 1; const int base_row = seg ? b * SEQ : ML + b * CTX, L = seg ? SEQ : CTX, k = seg ? ck - 2 : ck;
        LAS float* acs = acs0 + 384 * (ck & 1); LAS float* dtv = acs + 128; const LAS float* fjv = acs + 256;
        { const int j = F.tid >> 2, q = F.tid & 3;
#pragma unroll
          for (int e = 0; e < 4; ++e) { *(LAS v4u*)(Cb + j * SRS + 32 * q + 8 * e) = R.c[e]; *(LAS v4u*)(Bb + j * SRS + 32 * q + 8 * e) = R.b[e]; }
#pragma unroll
          for (int e = 0; e < 8; ++e) { const unsigned wv = e < 4 ? R.x[0][e & 3] : R.x[1][e & 3]; xT[(16 * q + 2 * e) * SRS + (j ^ (16 * q))] = (bf16)(wv & 0xffffu); xT[(16 * q + 2 * e + 1) * SRS + (j ^ (16 * q))] = (bf16)(wv >> 16); }
        }
        const SsdPre Rb = R;
        LDS_BARRIER();
        if (ck > 0) SSD_Y_STORE(ck - 1);
        if (ck + 1 < 34) { const int ck2 = ck + 1; const int seg2 = ck2 < 2 ? 0 : 1; ssd_prefetch(R, XBCC, DT, seg2 ? b * SEQ : ML + b * CTX, seg2 ? SEQ : CTX, seg2 ? ck2 - 2 : ck2, d, h, g, F.tid, lane); }
        const float atot = acs[127];
        { const int j = F.tid >> 2, q = F.tid & 3; const float wj = __expf(atot - acs[j]) * dtv[j];
#pragma unroll
          for (int e = 0; e < 4; ++e)
#pragma unroll
              for (int z = 0; z < 4; ++z) { const unsigned wv = Rb.b[e][z]; const int n = 32 * q + 8 * e + 2 * z;
                  const unsigned pw = pk2(bflo(wv) * wj, bfhi(wv) * wj); BwT[n * SRS + (j ^ (16 * q))] = (bf16)(pw & 0xffffu); BwT[(n + 1) * SRS + (j ^ (16 * q))] = (bf16)(pw >> 16); } }
        unsigned mpk[8][2];
        bf16x8 cfr[4];
#pragma unroll
        for (int ks = 0; ks < 4; ++ks) cfr[ks] = ssd_frag(Cb, 16 * w, 32 * ks, lane);
        { const float acs_i = acs[16 * w + lc]; const int irow = 16 * w + lc;
          const float a_w0 = acs[16 * w]; const float Ei = __expf(acs_i - a_w0);
          bf16x8 bfr[2][4];
#pragma unroll
          for (int ks = 0; ks < 4; ++ks) bfr[0][ks] = ssd_frag(Bb, 0, 32 * ks, lane);
#pragma unroll
          for (int jt = 0; jt < 8; ++jt) {
              if (jt <= w) {
                  if (jt + 1 <= w) {
#pragma unroll
                      for (int ks = 0; ks < 4; ++ks) bfr[(jt + 1) & 1][ks] = ssd_frag(Bb, 16 * (jt + 1), 32 * ks, lane); }
                  const f32x4 fj4 = *(const LAS f32x4*)(fjv + 16 * jt + 4 * q4); const float aend = acs[16 * jt + 15];
                  f32x4 gacc = {0.f, 0.f, 0.f, 0.f};
#pragma unroll
                  for (int ks = 0; ks < 4; ++ks) gacc = __builtin_amdgcn_mfma_f32_16x16x32_bf16(bfr[jt & 1][ks], cfr[ks], gacc, 0, 0, 0);
                  float mv[4];
                  if (jt < w) { const float et = Ei * __expf(a_w0 - aend);
#pragma unroll
                      for (int r = 0; r < 4; ++r) mv[r] = gacc[r] * (et * fj4[r]); }
                  else { const f32x4 aj4 = *(const LAS f32x4*)(acs + 16 * jt + 4 * q4), dj4 = *(const LAS f32x4*)(dtv + 16 * jt + 4 * q4);
#pragma unroll
                      for (int r = 0; r < 4; ++r) { const int j = 16 * jt + 4 * q4 + r; const float arg = (j <= irow) ? fminf(acs_i - aj4[r], 0.f) : -200.f; mv[r] = gacc[r] * (__expf(arg) * dj4[r]); } }
                  mpk[jt][0] = pk2(mv[0], mv[1]); mpk[jt][1] = pk2(mv[2], mv[3]);
              } else { mpk[jt][0] = 0u; mpk[jt][1] = 0u; } } }
        f32x4 accy[4];
#pragma unroll
        for (int pt = 0; pt < 4; ++pt) accy[pt] = (f32x4){0.f, 0.f, 0.f, 0.f};
#pragma unroll
        for (int kh = 0; kh < 2; ++kh) { bf16x8 sq[2][4];
#pragma unroll
          for (int ks = 0; ks < 2; ++ks)
#pragma unroll
              for (int pt = 0; pt < 4; ++pt) sq[ks][pt] = ssd_frag(Sb, 16 * pt, 32 * (2 * kh + ks), lane);
          __builtin_amdgcn_sched_barrier(0);
#pragma unroll
          for (int ks = 0; ks < 2; ++ks)
#pragma unroll
              for (int pt = 0; pt < 4; ++pt) accy[pt] = __builtin_amdgcn_mfma_f32_16x16x32_bf16(cfr[2 * kh + ks], sq[ks][pt], accy[pt], 0, 0, 0);
          __builtin_amdgcn_sched_barrier(0); }
        { float ei[4];
#pragma unroll
          for (int r = 0; r < 4; ++r) ei[r] = __expf(acs[16 * w + 4 * q4 + r]);
#pragma unroll
          for (int pt = 0; pt < 4; ++pt)
#pragma unroll
              for (int r = 0; r < 4; ++r) accy[pt][r] *= ei[r]; }
        if (ck + 1 < 34) SSD_DT_SCAN((ck + 1) & 1);
        LDS_BARRIER();
        { LAS bf16* mrow = Bb + (16 * w + lc) * SRS + 4 * q4;
#pragma unroll
          for (int jt = 0; jt < 8; ++jt) { v2u o; o.x = mpk[jt][0]; o.y = mpk[jt][1]; *(LAS v2u*)(mrow + 16 * jt) = o; } }
        LDS_BARRIER();
        { const float ed = __expf(atot);
#pragma unroll
          for (int pt = 0; pt < 4; ++pt) accs[pt] *= ed;
#pragma unroll
          for (int kh = 0; kh < 2; ++kh) { bf16x8 am[2], aw[2], xq[2][4];
#pragma unroll
              for (int ks = 0; ks < 2; ++ks) { am[ks] = ssd_frag(Bb, 16 * w, 32 * (2 * kh + ks), lane); aw[ks] = ssd_frag_sw(BwT, 16 * w, 32 * (2 * kh + ks), lane, 16 * (w >> 1));
#pragma unroll
                  for (int pt = 0; pt < 4; ++pt) xq[ks][pt] = ssd_frag_sw(xT, 16 * pt, 32 * (2 * kh + ks), lane, 16 * pt); }
              __builtin_amdgcn_sched_barrier(0);
#pragma unroll
              for (int ks = 0; ks < 2; ++ks)
#pragma unroll
                  for (int pt = 0; pt < 4; ++pt) { accy[pt] = __builtin_amdgcn_mfma_f32_16x16x32_bf16(am[ks], xq[ks][pt], accy[pt], 0, 0, 0); accs[pt] = __builtin_amdgcn_mfma_f32_16x16x32_bf16(aw[ks], xq[ks][pt], accs[pt], 0, 0, 0); }
              __builtin_amdgcn_sched_barrier(0); }
#pragma unroll
          for (int pt = 0; pt < 4; ++pt) { ypk[pt][0] = pk2(accy[pt][0], accy[pt][1]); ypk[pt][1] = pk2(accy[pt][2], accy[pt][3]); }
#pragma unroll
          for (int pt = 0; pt < 4; ++pt) { v2u o; o.x = pk2(accs[pt][0], accs[pt][1]); o.y = pk2(accs[pt][2], accs[pt][3]); *(LAS v2u*)(Sb + (16 * pt + lc) * SRS + 16 * w + 4 * q4) = o; } }
        LDS_BARRIER();
    }
    SSD_Y_STORE(33);
}

constexpr int CW_QHEAD = 8192;
__device__ __forceinline__ void mixer_phase_v2(const Params& P, Frame& F, int l) {
    const FftThr T = fft_thread_setup(F.tid);
    unsigned* head = (unsigned*)(P.ws + WS_CTL) + CW_QHEAD + 64 * l;
    volatile LAS unsigned* qw = (volatile LAS unsigned*)(F.lds + LDS_BYTES - 32);
    unsigned nxt = 0u; int tw_ok = 0;
    if (F.tid == 0) nxt = __hip_atomic_fetch_add(head, 1u, __ATOMIC_RELAXED, __HIP_MEMORY_SCOPE_AGENT);
    for (;;) {
        __syncthreads();
        if (F.tid == 0) qw[0] = nxt;
        __syncthreads();
        const int it = (int)qw[0];
        if (F.tid == 0 && it < 128 + 1024 + 1024) nxt = __hip_atomic_fetch_add(head, 1u, __ATOMIC_RELAXED, __HIP_MEMORY_SCOPE_AGENT);
        if (it >= 128 + 1024 + (l < DEPTH - 1 ? 1024 : 0)) break;
#ifndef SK_SSDN
        if (it < 128) { tw_ok = 0; ssd_mfma_item(P, F, l, it);
#ifdef REP_SSD
            ssd_mfma_item(P, F, l, it);
#endif
        }
        else
#endif
        if (it < 1152) { hyena_fft_item(P, F, l, it - 128, T, tw_ok);
#ifdef REP_HYL
            hyena_fft_item(P, F, l, it - 128, T, tw_ok);
#endif
        }
#ifndef SK_CTXH
        else { tw_ok = 0; hyena_ctx_item2(P, F, l, it - 1152);
#ifdef REP_HYC
            hyena_ctx_item2(P, F, l, it - 1152);
#endif
        }
#endif
    }
}

__device__ __forceinline__ void finalize_phase(const Params& P, Frame& F, int l) {
    unsigned char* ws = P.ws;
    bf16* Y = (bf16*)(ws + WS_Y);
    const bf16* ZTL = (const bf16*)(ws + WS_ZTL); const bf16* ZTC = (const bf16*)(ws + WS_ZTC);
    const bf16* YF = (const bf16*)(ws + WS_YF); const bf16* YB = (const bf16*)(ws + WS_YB);
    const bf16* XBCC = (const bf16*)(ws + WS_XBCC); const bf16* ZG = (const bf16*)(ws + WS_ZG);
    LAS float* zt = (LAS float*)F.lds;
    LAS float* red = zt + 128 * 65;
    LAS float* rsv = red + 512;
    for (int it = F.bid; it < ((l < DEPTH - 1 ? MROWS : ML) / 64) * 10; it += F.G) {
        const int tile = it / 10, part = it % 10, r0 = tile * 64;
        if (part < 8) {
            const int gh = part; const bf16* src; int L;
            if (r0 < ML) { src = ZTL + ((size_t)(r0 >> 12) * HYW + gh * 128) * SEQ + (r0 & 4095); L = SEQ; } else { const int rr = r0 - ML; src = ZTC + ((size_t)(rr >> 8) * HYW + gh * 128) * CTX + (rr & 255); L = CTX; }
            { const int ch = F.tid >> 2, q = F.tid & 3; const v4u a = *(const v4u*)(src + (size_t)ch * L + 16 * q), b2 = *(const v4u*)(src + (size_t)ch * L + 16 * q + 8);
              LAS float* dz = zt + ch * 65 + 16 * q;
#pragma unroll
              for (int e = 0; e < 4; ++e) { dz[2 * e] = bflo(a[e]); dz[2 * e + 1] = bfhi(a[e]); dz[8 + 2 * e] = bflo(b2[e]); dz[8 + 2 * e + 1] = bfhi(b2[e]); } }
            __syncthreads();
            { const int tt = F.tid & 63, w = F.tid >> 6; float ss = 0.f;
#pragma unroll
              for (int j = 0; j < 16; ++j) { const float z = zt[(w * 16 + j) * 65 + tt]; ss += z * z; }
              red[w * 64 + tt] = ss; }
            __syncthreads();
            if (F.tid < 64) { float s = 0.f;
#pragma unroll
                for (int w = 0; w < 8; ++w) s += red[w * 64 + F.tid];
                rsv[F.tid] = 1.0f / sqrtf(s * (1.0f / 128.0f) + EPS); }
            __syncthreads();
            { const int tt = F.tid >> 3, cq = F.tid & 7; const float rs = rsv[tt]; const float* nw = P.in[I_HNW] + l * HYW + gh * 128 + cq * 16; float o[16];
#pragma unroll
              for (int j = 0; j < 16; ++j) o[j] = zt[(cq * 16 + j) * 65 + tt] * rs * nw[j];
              v4u w0, w1; w0.x = pk2(o[0], o[1]); w0.y = pk2(o[2], o[3]); w0.z = pk2(o[4], o[5]); w0.w = pk2(o[6], o[7]); w1.x = pk2(o[8], o[9]); w1.y = pk2(o[10], o[11]); w1.z = pk2(o[12], o[13]); w1.w = pk2(o[14], o[15]);
              bf16* dst = Y + (size_t)(r0 + tt) * D + gh * 128 + cq * 16; *(v4u*)dst = w0; *(v4u*)(dst + 8) = w1; }
            __syncthreads();
        } else {
            const int gs = part - 8;
            for (int rr = F.wave; rr < 64; rr += NWAVES) {
                const size_t row = (size_t)(r0 + rr); const int ch = gs * 512 + F.lane * 8; const float Dh = P.in[I_SSDD][l * 16 + (ch >> 6)];
                const v4u fr = *(const v4u*)(YF + row * SSDW + ch), br = *(const v4u*)(YB + row * SSDW + ch);
                const v4u xr = *(const v4u*)(XBCC + row * XBCW + ch), zr = *(const v4u*)(ZG + row * SSDW + ch);
                float y[8]; float ss = 0.f;
#pragma unroll
                for (int e = 0; e < 4; ++e) { const float ya = (bflo(fr[e]) + bflo(br[e]) + Dh * bflo(xr[e])) * silu_f(bflo(zr[e]));
                    const float yb = (bfhi(fr[e]) + bfhi(br[e]) + Dh * bfhi(xr[e])) * silu_f(bfhi(zr[e]));
                    y[2 * e] = ya; y[2 * e + 1] = yb; ss += ya * ya + yb * yb; }
                const float rs = 1.0f / sqrtf(wave_sum(ss) * (1.0f / 512.0f) + EPS);
                const float* nw = P.in[I_SNW] + l * SSDW + ch;
                v4u w; w.x = pk2(y[0] * rs * nw[0], y[1] * rs * nw[1]); w.y = pk2(y[2] * rs * nw[2], y[3] * rs * nw[3]); w.z = pk2(y[4] * rs * nw[4], y[5] * rs * nw[5]); w.w = pk2(y[6] * rs * nw[6], y[7] * rs * nw[7]);
                *(v4u*)(Y + row * D + 1024 + ch) = w;
            }
        }
    }
}

#define RUN(g) (lo <= (g) && (g) < hi)
#define SEAM(g) do { if (RUN(g) && RUN((g) + 1)) xcd_barrier(bar); } while (0)
#ifndef HPAD
#define HPAD 0
#endif
constexpr int HP = DFF + HPAD;
template <int l> __device__ __forceinline__ void layer_phases(const Params& P, Frame& F, const XcdBarrier& bar, const int lo, const int hi) {
    unsigned char* ws = P.ws;
    const float* MOD = (const float*)(ws + WS_MOD);
    constexpr int gb = 1 + 9 * l;
#ifndef SK_NORM
    if (l == 0 && RUN(gb + 0)) filter_table_part(P, F, 0, F.bid, F.G);
    if (RUN(gb + 0)) norm_phase<0>(P, F, l, MROWS, (const float*)(ws + WS_Y), l > 0 ? 8 : 0, MOD + ((size_t)(l > 0 ? l - 1 : 0) * 5 + 4) * NMOD + 10240);
#ifdef REP_N1
    if (RUN(gb + 0) && l > 0) norm_phase<0>(P, F, l, MROWS, nullptr, 0, nullptr);
#endif
#endif
    SEAM(gb + 0);
#ifndef SK_G1
    if (RUN(gb + 1)) {
        pg8::Gemm g{(const bf16*)(ws + WS_XN), (const bf16*)(ws + WS_WIN) + (size_t)l * PROJP * D, MROWS, 5632, D, D}; pg8::StaticOrder S; S.init(MROWS, 5632, F.G, F.bid);
        pg8::EpiInProj E{(bf16*)(ws + WS_UTL), (bf16*)(ws + WS_UTC), (bf16*)(ws + WS_XBC), (bf16*)(ws + WS_ZG), (float*)(ws + WS_DT)};
        pg8::gemm_phase<pg8::EpiInProj, pg8::StaticOrder, true, true>(F.lds, g, S, E);
#ifdef REP_G1
        __syncthreads(); pg8::gemm_phase<pg8::EpiInProj, pg8::StaticOrder, true, true>(F.lds, g, S, E);
#endif
    }
#endif
    SEAM(gb + 1);
#ifndef SK_XBC
    if (RUN(gb + 2)) xbc_conv_phase(P, F, l);
#ifdef REP_XBC
    if (RUN(gb + 2)) xbc_conv_phase(P, F, l);
#endif
#endif
    SEAM(gb + 2);
#ifndef SK_MIX
    if (RUN(gb + 3)) mixer_phase_v2(P, F, l);
#ifdef REP_MIX
    if (RUN(gb + 3)) mixer_phase_v2(P, F, l);
#endif
#endif
    SEAM(gb + 3);
#ifndef SK_FIN
    if (RUN(gb + 4)) finalize_phase(P, F, l);
#ifdef REP_FIN
    if (RUN(gb + 4)) finalize_phase(P, F, l);
#endif
#endif
    SEAM(gb + 4);
#ifndef SK_G2
    if (RUN(gb + 5)) {
        pg8::Gemm g{(const bf16*)(ws + WS_Y), (const bf16*)(ws + WS_WOUT) + (size_t)l * D * D, ML, D, D, D}; pg8::StaticOrder S; S.init(ML, D, F.G, F.bid);
        pg8::EpiResid E{(bf16*)(ws + WS_XR), MOD + (size_t)l * 5 * NMOD, 4096, 1.0f};
        if (l < DEPTH - 1) {
            pg8::Gemm g2{(const bf16*)(ws + WS_Y), (const bf16*)(ws + WS_WOUT) + (size_t)l * D * D, MROWS, D, D / 4, D}; pg8::SplitKOrder S2; S2.init(ML / 256, MC / 256, D, 4, D / 4, F.G, F.bid);
            pg8::EpiPartial E2{(bf16*)(ws + WS_MIX), (D / 4) * 2, ML, MC};
            pg8::gemm_phase<pg8::EpiPartial, pg8::SplitKOrder, true, true>(F.lds, g2, S2, E2);
            __syncthreads();
        }
        pg8::gemm_phase<pg8::EpiResid, pg8::StaticOrder, true, true>(F.lds, g, S, E);
    }
#endif
    SEAM(gb + 5);
#ifndef SK_NORM
    if (RUN(gb + 6)) norm_phase<1>(P, F, l, l < DEPTH - 1 ? MROWS : ML, (const float*)(ws + WS_MIX), l < DEPTH - 1 ? 4 : 0, MOD + ((size_t)l * 5 + 4) * NMOD + 4096);
#ifdef REP_N2
    if (RUN(gb + 6)) norm_phase<1>(P, F, l, l < DEPTH - 1 ? MROWS : ML, nullptr, 0, nullptr);
#endif
#endif
    SEAM(gb + 6);
#ifndef SK_G3
    if (RUN(gb + 7)) {
        constexpr int MR = l < DEPTH - 1 ? MROWS : ML;
        pg8::Gemm g{(const bf16*)(ws + WS_XN), (const bf16*)(ws + WS_W1) + (size_t)l * DFF * D, MR, DFF, D, D}; pg8::StaticOrder S; S.init(MR, DFF, F.G, F.bid);
        pg8::EpiSqRelu E{(bf16*)(ws + WS_H), HP};
        if (l < DEPTH - 1) {
            const int nunits = (MR / 256) * (DFF / 256), nlong = nunits - (nunits / F.G) * F.G;
            if (F.bid >= nlong) { filter_table_part(P, F, l + 1, F.bid - nlong, F.G - nlong); __syncthreads(); }
        }
        pg8::gemm_phase<pg8::EpiSqRelu, pg8::StaticOrder, true, true>(F.lds, g, S, E);
#ifdef REP_G3
        __syncthreads(); pg8::gemm_phase<pg8::EpiSqRelu, pg8::StaticOrder, true, true>(F.lds, g, S, E);
#endif
    }
#endif
    SEAM(gb + 7);
#ifndef SK_G4
    if (RUN(gb + 8)) {
        pg8::Gemm g{(const bf16*)(ws + WS_H), (const bf16*)(ws + WS_W2) + (size_t)l * D * DFF, ML, D, DFF, DFF, HP}; pg8::StaticOrder S; S.init(ML, D, F.G, F.bid, 4);
        pg8::EpiResid E{(bf16*)(ws + WS_XR), MOD + (size_t)l * 5 * NMOD, 10240, 1.0f};
        const bool ctx_first = ((F.bid >> 3) & 1) != 0;
        if (l < DEPTH - 1 && ctx_first) {
            pg8::Gemm g2{(const bf16*)(ws + WS_H), (const bf16*)(ws + WS_W2) + (size_t)l * D * DFF, MROWS, D, DFF / 8, DFF, HP}; pg8::SplitKOrder S2; S2.init(ML / 256, MC / 256, D, 8, DFF / 8, F.G, F.bid);
            pg8::EpiPartial E2{(bf16*)(ws + WS_Y), (DFF / 8) * 2, ML, MC};
            pg8::gemm_phase<pg8::EpiPartial, pg8::SplitKOrder, true, true>(F.lds, g2, S2, E2);
            __syncthreads();
        }
        pg8::gemm_phase<pg8::EpiResid, pg8::StaticOrder, true, true>(F.lds, g, S, E);
        if (l < DEPTH - 1 && !ctx_first) {
            __syncthreads();
            pg8::Gemm g2{(const bf16*)(ws + WS_H), (const bf16*)(ws + WS_W2) + (size_t)l * D * DFF, MROWS, D, DFF / 8, DFF, HP}; pg8::SplitKOrder S2; S2.init(ML / 256, MC / 256, D, 8, DFF / 8, F.G, F.bid);
            pg8::EpiPartial E2{(bf16*)(ws + WS_Y), (DFF / 8) * 2, ML, MC};
            pg8::gemm_phase<pg8::EpiPartial, pg8::SplitKOrder, true, true>(F.lds, g2, S2, E2);
        }
    }
#endif
    SEAM(gb + 8);
}

__global__ void __launch_bounds__(NTHR, 2) fwd_kernel(Params P) {
    extern __shared__ __attribute__((aligned(16))) unsigned char lds_raw[];
    Frame F;
    F.lds = (LAS unsigned char*)lds_raw;
    F.tid = threadIdx.x; F.lane = F.tid & 63; F.wave = __builtin_amdgcn_readfirstlane(F.tid >> 6); F.G = gridDim.x; F.bid = blockIdx.x;
    unsigned char* ws = P.ws;
    volatile LAS unsigned* bst = (volatile LAS unsigned*)(F.lds + LDS_BYTES - 16);
    if (F.tid < 4) bst[F.tid] = 0u;
    __syncthreads();
    const int lo = P.ph_lo, hi = P.ph_hi;
    XcdBarrier bar; bar.bar = (unsigned*)(ws + WS_CTL) + CW_BAR; bar.x = 0; bar.st = bst;
    if (hi - lo > 1) bar = xcd_barrier_post((unsigned*)(ws + WS_CTL) + CW_BAR, bst);
#ifndef SK_PRO
    if (RUN(0)) prologue_phase(P, F);
#ifdef REP_PRO
    if (RUN(0)) prologue_phase(P, F);
#endif
#endif
    SEAM(0);
    layer_phases<0>(P, F, bar, lo, hi);
#ifndef ONE_LAYER
    layer_phases<1>(P, F, bar, lo, hi);
    layer_phases<2>(P, F, bar, lo, hi);
    layer_phases<3>(P, F, bar, lo, hi);
#endif
#ifndef SK_NORM
    if (RUN(37)) norm_phase<2>(P, F, 0, ML, nullptr, 0, nullptr);
#endif
}
#undef RUN
#undef SEAM

#ifndef N_LAUNCH_MODE
#define N_LAUNCH_MODE 1
#endif
extern "C" void kernel_launch(void* const* d_in, const int* in_sizes, int n_in, void* d_out, int out_size, void* d_ws, size_t ws_size, hipStream_t stream) {
    static int grid = 0;
    if (grid == 0) {
        if (n_in != N_IN || out_size != ML * D || ws_size < WS_END) { fprintf(stderr, "kernel_launch: unexpected shapes: n_in %d out %d ws %zu (need %zu)\n", n_in, out_size, ws_size, (size_t)WS_END); grid = -1; return; }
        int dev = 0, cus = 0;
        if (hipGetDevice(&dev) != hipSuccess || hipDeviceGetAttribute(&cus, hipDeviceAttributeMultiprocessorCount, dev) != hipSuccess) { grid = -1; return; }
        if (hipFuncSetAttribute((const void*)fwd_kernel, hipFuncAttributeMaxDynamicSharedMemorySize, LDS_BYTES) != hipSuccess) { fprintf(stderr, "kernel_launch: hipFuncSetAttribute failed\n"); grid = -1; return; }
        int per_cu = 0;
        if (hipOccupancyMaxActiveBlocksPerMultiprocessor(&per_cu, (const void*)fwd_kernel, NTHR, LDS_BYTES) != hipSuccess || per_cu < 1) fprintf(stderr, "kernel_launch: occupancy query reports %d\n", per_cu);
        (void)hipGetLastError();
        grid = cus;
    }
    if (grid < 0) return;
    if (hipMemsetAsync((char*)d_ws + WS_CTL, 0, CTL_ZERO_BYTES, stream) != hipSuccess) return;
    Params p{};
    for (int i = 0; i < N_IN; ++i) p.in[i] = (const float*)d_in[i];
    p.out = (float*)d_out; p.ws = (unsigned char*)d_ws;
#if N_LAUNCH_MODE == 1
    p.ph_lo = 0; p.ph_hi = NPH;
    hipLaunchKernelGGL(fwd_kernel, dim3(grid), dim3(NTHR), LDS_BYTES, stream, p);
#else
    for (int g = 0; g < NPH; ++g) { p.ph_lo = g; p.ph_hi = g + 1; hipLaunchKernelGGL(fwd_kernel, dim3(grid), dim3(NTHR), LDS_BYTES, stream, p); }
#endif
}
```
